# Optimizing an MI355X kernel written in HIP

```python
import jax
import jax.numpy as jnp
from jax import lax
import numpy as np

D_MODEL = 1024
BATCH = 2
SEQ = 16384
DEPTH = 2

CTX_LEN = 256
GRID_W = 64
BLOCK = 128
NORM_EPS = 1e-6
ROPE_BASE = 10000.0
NEG_INF = -1e30
F32 = jnp.float32

MLA_HEADS = 8
MLA_NOPE = 64
MLA_ROPE = 32
MLA_V = 64
Q_LORA = 256
KV_LORA = 128
RET_HEADS = 4
RET_DK = 128
RET_DV = 128
RET_CHUNK = 128
RET_DECAY_EXP_FWD = 5.0
RET_DECAY_EXP_BWD = 5.5
RET_GN_EPS = 1e-5
RWKV_HEADS = 8
RWKV_HD = 64
RWKV_DIM = RWKV_HEADS * RWKV_HD
DECAY_LORA = 64
AAA_LORA = 64
GATE_LORA = 128
RWKV_LN_EPS = 64e-5
WIN_HEADS = 8
WIN_KV_HEADS = 2
WIN_GROUP = WIN_HEADS // WIN_KV_HEADS
WIN_HD = 64
WINDOW = 128
N_EXPERTS = 16
EXPERT_FF = 1536
EC_FACTOR = 2

MIX_WIDTH = MLA_HEADS * MLA_V + RET_HEADS * RET_DV
EVEN_SPLITS = (Q_LORA, KV_LORA, MLA_ROPE, RET_HEADS * RET_DK, RET_HEADS * RET_DK, RET_HEADS * RET_DV, RET_HEADS * RET_DV)
RWKV_SPLITS = (RWKV_DIM, RWKV_DIM, RWKV_DIM, DECAY_LORA, DECAY_LORA, AAA_LORA, AAA_LORA, GATE_LORA)
WIN_SPLITS = (WIN_HEADS * WIN_HD, WIN_KV_HEADS * WIN_HD, WIN_KV_HEADS * WIN_HD)
EVEN_IN = sum(EVEN_SPLITS)
RWKV_IN = sum(RWKV_SPLITS)
ODD_IN = RWKV_IN + sum(WIN_SPLITS)
N_EVEN = (DEPTH + 1) // 2
N_ODD = DEPTH // 2

kernel_name = 'hybrid_mla_retention_rwkv7_swa_ec_moe_diffusion'


def split_cols(p, sizes):
    return jnp.split(p, np.cumsum(sizes)[:-1].tolist(), axis=-1)


def maybe_flip(t, rev):
    return jnp.flip(t, axis=1) if rev else t


def rmsnorm(x, g):
    xf = x.astype(F32)
    y = xf * lax.rsqrt(jnp.mean(xf * xf, axis=-1, keepdims=True) + NORM_EPS)
    return (y * g.astype(F32)).astype(x.dtype)


def head_layernorm(y, eps):
    yc = y - jnp.mean(y, axis=-1, keepdims=True)
    return yc * lax.rsqrt(jnp.mean(yc * yc, axis=-1, keepdims=True) + eps)


def modulation(cvec, w, b):
    m = jax.nn.silu(cvec) @ w + b
    if m.ndim == 2:
        m = m[:, None, :]
    return jnp.split(m, 6, axis=-1)


def modulate(h, shift, scale):
    return h * (1.0 + scale) + shift


def rope_rotate(x, pos):
    half = x.shape[-1] // 2
    inv_freq = ROPE_BASE ** (-jnp.arange(half, dtype=F32) / half)
    ang = pos.astype(F32)[:, None] * inv_freq[None, :]
    cos = jnp.cos(ang)[None, :, None, :].astype(x.dtype)
    sin = jnp.sin(ang)[None, :, None, :].astype(x.dtype)
    x1, x2 = x[..., :half], x[..., half:]
    return jnp.concatenate([x1 * cos - x2 * sin, x1 * sin + x2 * cos], axis=-1)


def axial_rope(x):
    t = jnp.arange(x.shape[1])
    half = x.shape[-1] // 2
    return jnp.concatenate([rope_rotate(x[..., :half], t // GRID_W),
                            rope_rotate(x[..., half:], t % GRID_W)], axis=-1)


def centred_shift(p):
    z = jnp.zeros_like(p[:, :1])
    return 0.5 * (jnp.concatenate([z, p[:, :-1]], axis=1) + jnp.concatenate([p[:, 1:], z], axis=1))


def mla_keys_values(ckv, kr, kv_norm_g, w_ukv, rotary):
    B, N, _ = ckv.shape
    kv = (rmsnorm(ckv, kv_norm_g) @ w_ukv).reshape(B, N, MLA_HEADS, MLA_NOPE + MLA_V)
    k_nope, v = kv[..., :MLA_NOPE], kv[..., MLA_NOPE:]
    kr = kr[:, :, None, :]
    if rotary:
        kr = axial_rope(kr)
    k = jnp.concatenate([k_nope, jnp.broadcast_to(kr, (B, N, MLA_HEADS, MLA_ROPE))], axis=-1)
    return k, v


def mla_queries(cq, q_norm_g, w_uq, rotary):
    B, N, _ = cq.shape
    q = (rmsnorm(cq, q_norm_g) @ w_uq).reshape(B, N, MLA_HEADS, MLA_NOPE + MLA_ROPE)
    if rotary:
        q = jnp.concatenate([q[..., :MLA_NOPE], axial_rope(q[..., MLA_NOPE:])], axis=-1)
    return q


def dense_block_attention(q, k, v):
    B, N, H, d = q.shape
    nb = N // BLOCK
    scale = d ** -0.5
    qb = jnp.moveaxis(q.reshape(B, nb, BLOCK, H, d), 1, 0)

    def attend(qblk):
        s = jnp.einsum('bqhd,bkhd->bhqk', qblk, k).astype(F32) * scale
        p = jax.nn.softmax(s, axis=-1).astype(v.dtype)
        return jnp.einsum('bhqk,bkhv->bqhv', p, v)

    o = lax.map(attend, qb)
    return jnp.moveaxis(o, 0, 1).reshape(B, N, H * v.shape[-1])


def retention_state_update(S, kd, v, chunk_decay):
    return S * chunk_decay[None, :, None, None] + jnp.einsum('bjhd,bjhv->bhdv', kd, v)


def retention_chunks(q, k, v, log_gamma, state0):
    B, N, H, _ = k.shape
    L = RET_CHUNK
    nc = N // L
    pos = jnp.arange(L, dtype=F32)
    diff = pos[:, None] - pos[None, :]
    d_in = jnp.where(diff >= 0, jnp.exp(log_gamma[:, None, None] * jnp.maximum(diff, 0.0)), 0.0)
    q_dec = jnp.exp(log_gamma[None, :] * (pos[:, None] + 1.0))
    k_dec = jnp.exp(log_gamma[None, :] * (L - 1.0 - pos[:, None]))
    c_dec = jnp.exp(log_gamma * L)
    to_chunks = lambda t: jnp.moveaxis(t.astype(F32).reshape(B, nc, L, H, t.shape[-1]), 1, 0)
    kc, vc = to_chunks(k), to_chunks(v)
    kdc = kc * k_dec[None, None, :, :, None]
    if q is None:
        def state_step(S, xs):
            return retention_state_update(S, xs[0], xs[1], c_dec), None
        S, _ = lax.scan(state_step, state0, (kdc, vc))
        return None, S
    qc = to_chunks(q)

    def step(S, xs):
        qi, ki, kdi, vi = xs
        s = jnp.einsum('bihd,bjhd->bhij', qi, ki) * d_in
        o = (jnp.einsum('bhij,bjhv->bihv', s, vi)
             + jnp.einsum('bihd,bhdv->bihv', qi * q_dec[None, :, :, None], S))
        return retention_state_update(S, kdi, vi, c_dec), o

    S, o = lax.scan(step, state0, (qc, kc, kdc, vc))
    return jnp.moveaxis(o, 0, 1).reshape(B, N, H, v.shape[-1]), S


def bidirectional_retention(q_l, k_l, v_l, q_c, k_c, v_c):
    S0 = jnp.zeros((k_l.shape[0], RET_HEADS, RET_DK, RET_DV), F32)
    outs_l, outs_c = [], []
    for exp0, rev in ((RET_DECAY_EXP_FWD, False), (RET_DECAY_EXP_BWD, True)):
        log_gamma = jnp.log1p(-2.0 ** (-exp0 - jnp.arange(RET_HEADS, dtype=F32)))
        oc, S = retention_chunks(None if q_c is None else maybe_flip(q_c, rev),
                                 maybe_flip(k_c, rev), maybe_flip(v_c, rev), log_gamma, S0)
        ol, _ = retention_chunks(maybe_flip(q_l, rev), maybe_flip(k_l, rev), maybe_flip(v_l, rev), log_gamma, S)
        outs_l.append(maybe_flip(ol, rev))
        if q_c is not None:
            outs_c.append(maybe_flip(oc, rev))
    out_c = outs_c[0] + outs_c[1] if q_c is not None else None
    return outs_l[0] + outs_l[1], out_c


def retention_output(o, g, gn_g):
    B, N = o.shape[:2]
    y = head_layernorm(o, RET_GN_EPS).reshape(B, N, RET_HEADS * RET_DV) * gn_g
    return jax.nn.silu(g) * y.astype(g.dtype)


def even_mixer(a_lat, a_ctx, w_in, w_out, q_norm_g, w_uq, kv_norm_g, w_ukv, ret_norm_g, need_ctx):
    n_lat, n_ctx = a_lat.shape[1], a_ctx.shape[1]
    cq_l, ckv_l, kr_l, rq_l, rk_l, rv_l, rg_l = split_cols(a_lat @ w_in, EVEN_SPLITS)
    cq_c, ckv_c, kr_c, rq_c, rk_c, rv_c, rg_c = split_cols(a_ctx @ w_in, EVEN_SPLITS)
    k_l, v_l = mla_keys_values(ckv_l, kr_l, kv_norm_g, w_ukv, True)
    k_c, v_c = mla_keys_values(ckv_c, kr_c, kv_norm_g, w_ukv, False)
    q_l = mla_queries(cq_l, q_norm_g, w_uq, True)
    att_l = dense_block_attention(q_l, jnp.concatenate([k_c, k_l], axis=1), jnp.concatenate([v_c, v_l], axis=1))
    heads = lambda t: t.reshape(t.shape[0], t.shape[1], RET_HEADS, -1)
    pos_c = jnp.arange(n_ctx)
    pos_l = n_ctx + jnp.arange(n_lat)
    k_scale = RET_DK ** -0.5
    ret_q_l = rope_rotate(heads(rq_l), pos_l)
    ret_k_l = rope_rotate(heads(rk_l), pos_l) * k_scale
    ret_k_c = rope_rotate(heads(rk_c), pos_c) * k_scale
    ret_q_c = rope_rotate(heads(rq_c), pos_c) if need_ctx else None
    ret_l, ret_c = bidirectional_retention(ret_q_l, ret_k_l, heads(rv_l), ret_q_c, ret_k_c, heads(rv_c))
    y_lat = jnp.concatenate([att_l, retention_output(ret_l, rg_l, ret_norm_g)], axis=-1) @ w_out
    if not need_ctx:
        return y_lat, None
    att_c = dense_block_attention(mla_queries(cq_c, q_norm_g, w_uq, False), k_c, v_c)
    y_ctx = jnp.concatenate([att_c, retention_output(ret_c, rg_c, ret_norm_g)], axis=-1) @ w_out
    return y_lat, y_ctx


def rwkv_features(p, mu, w0, w2, a0, a2, k_k, k_a):
    B, N, _ = p.shape
    p = (p + mu * (centred_shift(p) - p)).astype(F32)
    r, k, v, wl_f, wl_b, al_f, al_b, gl = split_cols(p, RWKV_SPLITS)
    heads = lambda t: t.reshape(B, N, RWKV_HEADS, RWKV_HD)
    kk = heads(k * k_k)
    kk = kk * lax.rsqrt(jnp.sum(kk * kk, axis=-1, keepdims=True) + 1e-12)
    decays, rates, keys = [], [], []
    for d, (wl, al) in enumerate(((wl_f, al_f), (wl_b, al_b))):
        w = -jax.nn.softplus(-(w0[d] + jnp.tanh(wl) @ w2[d])) - 0.5
        a = jax.nn.sigmoid(a0[d] + al @ a2[d])
        decays.append(heads(jnp.exp(-jnp.exp(w))))
        rates.append(heads(a))
        keys.append(heads(k * (1.0 + (a - 1.0) * k_a)))
    return heads(r), heads(k), heads(v), kk, decays, rates, keys, gl


def rwkv_update(S, dec, k, v, kk, a):
    sa = jnp.einsum('bhvk,bhk->bhv', S, -kk)
    return (S * dec[:, :, None, :] + sa[..., None] * (kk * a)[:, :, None, :]
            + v[..., None] * k[:, :, None, :])


def rwkv_scan(r, dec, k, v, kk, a, S0):
    seq = lambda t: jnp.moveaxis(t, 1, 0)
    rest = tuple(seq(t) for t in (dec, k, v, kk, a))
    if r is None:
        def state_step(S, xs):
            return rwkv_update(S, *xs), None
        S, _ = lax.scan(state_step, S0, rest)
        return None, S

    def step(S, xs):
        S = rwkv_update(S, *xs[1:])
        return S, jnp.einsum('bhvk,bhk->bhv', S, xs[0])

    S, y = lax.scan(step, S0, (seq(r),) + rest)
    return jnp.moveaxis(y, 0, 1), S


def bidirectional_rwkv(f_l, f_c, need_ctx):
    r_l, _, v_l, kk_l, dec_l, a_l, key_l, _ = f_l
    r_c, _, v_c, kk_c, dec_c, a_c, key_c, _ = f_c
    S0 = jnp.zeros((r_l.shape[0], RWKV_HEADS, RWKV_HD, RWKV_HD), F32)
    ys_l, ys_c = [], []
    for d, rev in ((0, False), (1, True)):
        f = lambda t: maybe_flip(t, rev)
        yc, S = rwkv_scan(f(r_c) if need_ctx else None, f(dec_c[d]), f(key_c[d]), f(v_c), f(kk_c), f(a_c[d]), S0)
        yl, _ = rwkv_scan(f(r_l), f(dec_l[d]), f(key_l[d]), f(v_l), f(kk_l), f(a_l[d]), S)
        ys_l.append(f(yl))
        if need_ctx:
            ys_c.append(f(yc))
    y_c = ys_c[0] + ys_c[1] if need_ctx else None
    return ys_l[0] + ys_l[1], y_c


def rwkv_output(y, feats, g2, r_k, ln_g, ln_b):
    r, k, v, gl = feats[0], feats[1], feats[2], feats[7]
    B, N = y.shape[:2]
    yn = head_layernorm(y, RWKV_LN_EPS).reshape(B, N, RWKV_DIM) * ln_g + ln_b
    bonus = (jnp.sum(r * k * r_k, axis=-1, keepdims=True) * v).reshape(B, N, RWKV_DIM)
    return (yn + bonus) * (jax.nn.sigmoid(gl) @ g2)


def sink_attend(q, k, v, sink, mask):
    s = jnp.einsum('bqkgd,bjkd->bkgqj', q, k).astype(F32) * (WIN_HD ** -0.5)
    if mask is not None:
        s = jnp.where(mask, s, NEG_INF)
    sk = sink.astype(F32).reshape(1, WIN_KV_HEADS, WIN_GROUP, 1, 1)
    m = jnp.maximum(jnp.max(s, axis=-1, keepdims=True), sk)
    e = jnp.exp(s - m)
    p = (e / (jnp.sum(e, axis=-1, keepdims=True) + jnp.exp(sk - m))).astype(v.dtype)
    return jnp.einsum('bkgqj,bjkd->bqkgd', p, v)


def window_attention(q, k, v, k_ctx, v_ctx, sink):
    B, N = q.shape[:2]
    nb = N // BLOCK
    pad = ((0, 0), (BLOCK, BLOCK), (0, 0), (0, 0))
    kp, vp = jnp.pad(k, pad), jnp.pad(v, pad)
    qb = jnp.moveaxis(q.reshape(B, nb, BLOCK, WIN_KV_HEADS, WIN_GROUP, WIN_HD), 1, 0)
    qi = jnp.arange(BLOCK)[:, None]
    kj = jnp.arange(3 * BLOCK)[None, :]
    in_band = jnp.abs(kj - BLOCK - qi) <= WINDOW
    ctx_ok = jnp.ones((BLOCK, k_ctx.shape[1]), dtype=bool)

    def attend(args):
        blk, qblk = args
        start = blk * BLOCK
        kw = lax.dynamic_slice_in_dim(kp, start, 3 * BLOCK, axis=1)
        vw = lax.dynamic_slice_in_dim(vp, start, 3 * BLOCK, axis=1)
        kpos = start - BLOCK + kj
        mask = jnp.concatenate([in_band & (kpos >= 0) & (kpos < N), ctx_ok], axis=-1)
        return sink_attend(qblk, jnp.concatenate([kw, k_ctx], axis=1), jnp.concatenate([vw, v_ctx], axis=1), sink, mask)

    o = lax.map(attend, (jnp.arange(nb), qb))
    return jnp.moveaxis(o, 0, 1).reshape(B, N, WIN_HEADS * WIN_HD)


def odd_mixer(a_lat, a_ctx, w_in, w_out, mu, w0, w2, a0, a2, g2, k_k, k_a, r_k, ln_g, ln_b, sink, need_ctx):
    B, n_lat = a_lat.shape[:2]
    n_ctx = a_ctx.shape[1]
    rw_l, wq_l, wk_l, wv_l = split_cols(a_lat @ w_in, (RWKV_IN,) + WIN_SPLITS)
    rw_c, wq_c, wk_c, wv_c = split_cols(a_ctx @ w_in, (RWKV_IN,) + WIN_SPLITS)
    f_l = rwkv_features(rw_l, mu, w0, w2, a0, a2, k_k, k_a)
    f_c = rwkv_features(rw_c, mu, w0, w2, a0, a2, k_k, k_a)
    y_l, y_c = bidirectional_rwkv(f_l, f_c, need_ctx)
    rwkv_l = rwkv_output(y_l, f_l, g2, r_k, ln_g, ln_b).astype(a_lat.dtype)
    kvh = lambda t, n: t.reshape(B, n, WIN_KV_HEADS, WIN_HD)
    q_l = axial_rope(wq_l.reshape(B, n_lat, WIN_HEADS, WIN_HD)).reshape(B, n_lat, WIN_KV_HEADS, WIN_GROUP, WIN_HD)
    k_l = axial_rope(kvh(wk_l, n_lat))
    k_c, v_c = kvh(wk_c, n_ctx), kvh(wv_c, n_ctx)
    win_l = window_attention(q_l, k_l, kvh(wv_l, n_lat), k_c, v_c, sink)
    y_lat = jnp.concatenate([rwkv_l, win_l], axis=-1) @ w_out
    if not need_ctx:
        return y_lat, None
    rwkv_c = rwkv_output(y_c, f_c, g2, r_k, ln_g, ln_b).astype(a_ctx.dtype)
    q_c = wq_c.reshape(B, n_ctx, WIN_KV_HEADS, WIN_GROUP, WIN_HD)
    win_c = sink_attend(q_c, k_c, v_c, sink, None).reshape(B, n_ctx, WIN_HEADS * WIN_HD)
    y_ctx = jnp.concatenate([rwkv_c, win_c], axis=-1) @ w_out
    return y_lat, y_ctx


def expert_choice_ffn(h, w_router, w_gate, w_up, w_down):
    B, N, D = h.shape
    cap = EC_FACTOR * N // N_EXPERTS
    aff = jax.nn.softmax(jnp.einsum('bnd,de->bne', h, w_router).astype(F32), axis=-1)
    gate, idx = lax.top_k(jnp.swapaxes(aff, 1, 2), cap)
    xs = jax.vmap(lambda hb, ib: hb[ib])(h, idx)
    u = jax.nn.silu(jnp.einsum('becd,edf->becf', xs, w_gate)) * jnp.einsum('becd,edf->becf', xs, w_up)
    y = jnp.einsum('becf,efd->becd', u, w_down) * gate[..., None].astype(h.dtype)
    return jax.vmap(lambda yb, ib: jnp.zeros((N, D), h.dtype).at[ib.reshape(-1)].add(yb.reshape(-1, D)))(y, idx)


def setup_inputs(seed: int = 0) -> dict:
    key = jax.random.key(seed)
    ks = iter(jax.random.split(key, 48))
    D = D_MODEL
    nrm = lambda shape, scale: jax.random.normal(next(ks), shape, F32) * scale
    gain = lambda shape: 1.0 + nrm(shape, 0.02)
    return {
        'x': nrm((BATCH, SEQ, D), 1.0),
        'c': nrm((BATCH, D), 1.0),
        'ctx': nrm((BATCH, CTX_LEN, D), 1.0),
        'c_ctx': nrm((D,), 1.0),
        'ada_w': nrm((DEPTH, D, 6 * D), 0.5 * D ** -0.5),
        'ada_b': nrm((DEPTH, 6 * D), 0.02),
        'norm_mix_g': gain((DEPTH, D)),
        'norm_ffn_g': gain((DEPTH, D)),
        'final_g': gain((D,)),
        'ev_w_in': nrm((N_EVEN, D, EVEN_IN), D ** -0.5),
        'ev_w_out': nrm((N_EVEN, MIX_WIDTH, D), MIX_WIDTH ** -0.5),
        'mla_q_norm_g': gain((N_EVEN, Q_LORA)),
        'mla_w_uq': nrm((N_EVEN, Q_LORA, MLA_HEADS * (MLA_NOPE + MLA_ROPE)), Q_LORA ** -0.5),
        'mla_kv_norm_g': gain((N_EVEN, KV_LORA)),
        'mla_w_ukv': nrm((N_EVEN, KV_LORA, MLA_HEADS * (MLA_NOPE + MLA_V)), KV_LORA ** -0.5),
        'ret_norm_g': gain((N_EVEN, RET_HEADS * RET_DV)),
        'od_w_in': nrm((N_ODD, D, ODD_IN), D ** -0.5),
        'od_w_out': nrm((N_ODD, MIX_WIDTH, D), MIX_WIDTH ** -0.5),
        'rwkv_mu': jax.random.uniform(next(ks), (N_ODD, RWKV_IN), F32),
        'rwkv_w0': jax.random.uniform(next(ks), (N_ODD, 2, RWKV_DIM), F32, -6.0, -1.0),
        'rwkv_w2': nrm((N_ODD, 2, DECAY_LORA, RWKV_DIM), 0.1 * DECAY_LORA ** -0.5),
        'rwkv_a0': nrm((N_ODD, 2, RWKV_DIM), 0.5),
        'rwkv_a2': nrm((N_ODD, 2, AAA_LORA, RWKV_DIM), 0.1 * AAA_LORA ** -0.5),
        'rwkv_g2': nrm((N_ODD, GATE_LORA, RWKV_DIM), GATE_LORA ** -0.5),
        'rwkv_k_k': 0.85 + nrm((N_ODD, RWKV_DIM), 0.02),
        'rwkv_k_a': gain((N_ODD, RWKV_DIM)),
        'rwkv_r_k': nrm((N_ODD, RWKV_HEADS, RWKV_HD), 0.1),
        'rwkv_ln_g': gain((N_ODD, RWKV_DIM)),
        'rwkv_ln_b': nrm((N_ODD, RWKV_DIM), 0.02),
        'win_sink': nrm((N_ODD, WIN_HEADS), 1.0),
        'moe_router': nrm((DEPTH, D, N_EXPERTS), D ** -0.5),
        'moe_w_gate': nrm((DEPTH, N_EXPERTS, D, EXPERT_FF), D ** -0.5),
        'moe_w_up': nrm((DEPTH, N_EXPERTS, D, EXPERT_FF), D ** -0.5),
        'moe_w_down': nrm((DEPTH, N_EXPERTS, EXPERT_FF, D), EXPERT_FF ** -0.5),
    }


def reference(x, c, ctx, c_ctx, ada_w, ada_b, norm_mix_g, norm_ffn_g, final_g,
              ev_w_in, ev_w_out, mla_q_norm_g, mla_w_uq, mla_kv_norm_g, mla_w_ukv, ret_norm_g,
              od_w_in, od_w_out, rwkv_mu, rwkv_w0, rwkv_w2, rwkv_a0, rwkv_a2, rwkv_g2,
              rwkv_k_k, rwkv_k_a, rwkv_r_k, rwkv_ln_g, rwkv_ln_b, win_sink,
              moe_router, moe_w_gate, moe_w_up, moe_w_down):
    x_lat, x_ctx = x, ctx
    for layer in range(DEPTH):
        need_ctx = layer < DEPTH - 1
        sh1, sc1, g1, sh2, sc2, g2 = modulation(c, ada_w[layer], ada_b[layer])
        csh1, csc1, cg1, csh2, csc2, cg2 = modulation(c_ctx, ada_w[layer], ada_b[layer])
        a_lat = modulate(rmsnorm(x_lat, norm_mix_g[layer]), sh1, sc1)
        a_ctx = modulate(rmsnorm(x_ctx, norm_mix_g[layer]), csh1, csc1)
        if layer % 2 == 0:
            e = layer // 2
            y_lat, y_ctx = even_mixer(a_lat, a_ctx, ev_w_in[e], ev_w_out[e], mla_q_norm_g[e], mla_w_uq[e],
                                      mla_kv_norm_g[e], mla_w_ukv[e], ret_norm_g[e], need_ctx)
        else:
            o = layer // 2
            y_lat, y_ctx = odd_mixer(a_lat, a_ctx, od_w_in[o], od_w_out[o], rwkv_mu[o], rwkv_w0[o], rwkv_w2[o],
                                     rwkv_a0[o], rwkv_a2[o], rwkv_g2[o], rwkv_k_k[o], rwkv_k_a[o], rwkv_r_k[o],
                                     rwkv_ln_g[o], rwkv_ln_b[o], win_sink[o], need_ctx)
        x_lat = x_lat + g1 * y_lat
        h_lat = modulate(rmsnorm(x_lat, norm_ffn_g[layer]), sh2, sc2)
        x_lat = x_lat + g2 * expert_choice_ffn(h_lat, moe_router[layer], moe_w_gate[layer], moe_w_up[layer], moe_w_down[layer])
        if need_ctx:
            x_ctx = x_ctx + cg1 * y_ctx
            h_ctx = modulate(rmsnorm(x_ctx, norm_ffn_g[layer]), csh2, csc2)
            x_ctx = x_ctx + cg2 * expert_choice_ffn(h_ctx, moe_router[layer], moe_w_gate[layer], moe_w_up[layer], moe_w_down[layer])
    return rmsnorm(x_lat, final_g)
```

```cpp
#include <hip/hip_runtime.h>
#include <stdint.h>

typedef unsigned short bf16_t;
#define DI __device__ __forceinline__

DI float bf2f(bf16_t v) { return __uint_as_float(((unsigned)v) << 16); }
DI bf16_t f2bf(float f) { unsigned u = __float_as_uint(f); u += 0x7fffu + ((u >> 16) & 1u); return (bf16_t)(u >> 16); }

constexpr int D = 1024, NB = 2, SEQ = 16384, CTX = 256, TT = SEQ + CTX  , MT = NB * TT  ;
constexpr int EVEN_IN = 2464, ODD_IN = 2688, PLD = 2688;
constexpr int NE = 16, FF = 1536, CAP = 2048, CAPC = 32, ESLOTS = 2 * CAP + 2 * CAPC  ;
constexpr int C_CQ = 0, C_CKV = 256, C_KR = 384, C_RQ = 416, C_RK = 928, C_RV = 1440, C_RG = 1952;
constexpr int O_R = 0, O_K = 512, O_V = 1024, O_WL = 1536, O_AL = 1664, O_GL = 1792, O_WQ = 1920, O_WK = 2432, O_WV = 2560;

constexpr size_t MB = 1u << 20;
constexpr size_t OFF_CTL = 0;
constexpr size_t OFF_MOD = 64u << 10;
constexpr size_t OFF_XCTX = 1 * MB;
constexpr size_t OFF_AFF = 3 * MB;
constexpr size_t OFF_AFFC = 5 * MB;
constexpr size_t OFF_IDX = 5 * MB + (64u << 10);
constexpr size_t OFF_GATE = OFF_IDX + (256u << 10);
constexpr size_t OFF_IDXC = OFF_GATE + (256u << 10);
constexpr size_t OFF_GATEC = OFF_IDXC + (4u << 10);
constexpr size_t OFF_BC = 6 * MB;
constexpr size_t OFF_WS = 8 * MB;
constexpr size_t OFF_ABUF = 24 * MB;
constexpr size_t OFF_PROJ = 89 * MB;
constexpr size_t OFF_ERA = 260 * MB;
constexpr size_t OFF_Q = OFF_ERA;
constexpr size_t OFF_K = OFF_ERA + 49 * MB;
constexpr size_t OFF_VT = OFF_ERA + 98 * MB;
constexpr size_t OFF_KVS = OFF_ERA + 131 * MB;
constexpr size_t OFF_U = OFF_ERA;
constexpr size_t FSZ = (size_t)MT * 512 * 2;
constexpr size_t OFF_FR = OFF_ERA, OFF_FK = OFF_FR + FSZ, OFF_FV = OFF_FK + FSZ, OFF_FKK = OFF_FV + FSZ, OFF_FA0 = OFF_FKK + FSZ, OFF_FA1 = OFF_FA0 + FSZ,
                 OFF_FL0 = OFF_FA1 + FSZ, OFF_FL1 = OFF_FL0 + FSZ, OFF_FGT = OFF_FL1 + FSZ, OFF_LIN = OFF_FGT + FSZ;
constexpr size_t OFF_Y = OFF_LIN + 26 * MB;
constexpr size_t OFF_Q2 = OFF_Y + 64 * MB;
constexpr size_t OFF_K2 = OFF_Q2 + 32 * MB;
constexpr size_t OFF_V2T = OFF_K2 + 9 * MB;
constexpr size_t WS_END = OFF_V2T + 9 * MB;

DI int vperm(int t) { return (t & ~12) | ((t & 4) << 1) | ((t & 8) >> 1); }

DI float wave_sum(float v) {
#pragma unroll
    for (int o = 32; o > 0; o >>= 1) v += __shfl_xor(v, o);
    return v;
}
DI float block_sum256(float v, float* red) {
    v = wave_sum(v);
    __syncthreads();
    if ((threadIdx.x & 63) == 0) red[threadIdx.x >> 6] = v;
    __syncthreads();
    return red[0] + red[1] + red[2] + red[3];
}
DI float siluf(float x) { return x / (1.f + __expf(-x)); }
DI float sigmoidf(float x) { return 1.f / (1.f + __expf(-x)); }

__global__ void __launch_bounds__(256) k_mod(const float* c, const float* c_ctx, const float* ada_w, const float* ada_b, float* MOD) {
    __shared__ float sv[3][1024];
    const int layer = blockIdx.y, j = blockIdx.x * 256 + threadIdx.x;
    for (int i = threadIdx.x; i < 3072; i += 256) { int s = i >> 10, ii = i & 1023; float v = s < 2 ? c[s * 1024 + ii] : c_ctx[ii]; sv[s][ii] = v / (1.f + expf(-v)); }
    __syncthreads();
    const float* w = ada_w + (size_t)layer * 1024 * 6144 + j;
    float a0 = 0, a1 = 0, a2 = 0;
    for (int i = 0; i < 1024; ++i) { float ww = w[(size_t)i * 6144]; a0 += sv[0][i] * ww; a1 += sv[1][i] * ww; a2 += sv[2][i] * ww; }
    const float bb = ada_b[layer * 6144 + j];
    MOD[(layer * 3 + 0) * 6144 + j] = a0 + bb; MOD[(layer * 3 + 1) * 6144 + j] = a1 + bb; MOD[(layer * 3 + 2) * 6144 + j] = a2 + bb;
}

__global__ void __launch_bounds__(256) k_norm_mod(const float* xlat, const float* xctx, const float* g, const float* MODl, int shIdx, bf16_t* out,
                                                   const float* wr, float* AFF, float* AFFC, int lat_only) {
    __shared__ float red[4]; __shared__ float lg[4][16];
    const int r = blockIdx.x, b = r / TT, t = r % TT, tid = threadIdx.x;
    if (lat_only && t < CTX) return;
    const float* src = t < CTX ? xctx + (size_t)(b * CTX + t) * D : xlat + ((size_t)b * SEQ + (t - CTX)) * D;
    const int s = t < CTX ? 2 : b;
    const float4 xv = *(const float4*)(src + tid * 4);
    float ss = xv.x * xv.x + xv.y * xv.y + xv.z * xv.z + xv.w * xv.w;
    ss = block_sum256(ss, red);
    const float rstd = rsqrtf(ss * (1.f / 1024.f) + 1e-6f);
    const float* sh = MODl + s * 6144 + shIdx * 1024, *sc = sh + 1024;
    float xs[4] = {xv.x, xv.y, xv.z, xv.w}, h[4];
#pragma unroll
    for (int j = 0; j < 4; ++j) { const int i = tid * 4 + j; h[j] = (xs[j] * rstd * g[i]) * (1.f + sc[i]) + sh[i]; }
    ushort4 o; o.x = f2bf(h[0]); o.y = f2bf(h[1]); o.z = f2bf(h[2]); o.w = f2bf(h[3]);
    *(ushort4*)(out + (size_t)r * D + tid * 4) = o;
    if (wr) {
        float p[16];
#pragma unroll
        for (int e = 0; e < 16; ++e) p[e] = 0.f;
#pragma unroll
        for (int j = 0; j < 4; ++j) { const float* w = wr + (size_t)(tid * 4 + j) * 16;
#pragma unroll
            for (int e = 0; e < 16; ++e) p[e] += h[j] * w[e]; }
#pragma unroll
        for (int e = 0; e < 16; ++e) p[e] = wave_sum(p[e]);
        if ((tid & 63) == 0) {
#pragma unroll
            for (int e = 0; e < 16; ++e) lg[tid >> 6][e] = p[e]; }
        __syncthreads();
        if (tid < 16) {
            float l[16], m = -1e30f;
            for (int e = 0; e < 16; ++e) { l[e] = lg[0][e] + lg[1][e] + lg[2][e] + lg[3][e]; m = fmaxf(m, l[e]); }
            float sum = 0.f; for (int e = 0; e < 16; ++e) sum += expf(l[e] - m);
            const float a = expf(l[tid] - m) / sum;
            if (t < CTX) AFFC[(b * 16 + tid) * CTX + t] = a; else AFF[(size_t)(b * 16 + tid) * SEQ + (t - CTX)] = a;
        }
    }
}

struct ALoad {
    const bf16_t* base; int ld; int mode; const int* idx; const int* idxc; size_t zstride; int col0;
    DI const bf16_t* rowptr(int z, int m) const {
        if (mode == 0) return base + (size_t)m * ld + col0;
        if (mode == 1) {
            int r;
            if (m < 2 * CAP) { const int b = m / CAP; r = b * TT + CTX + idx[(b * NE + z) * CAP + (m % CAP)]; }
            else { const int mc = m - 2 * CAP, b = mc / CAPC; r = b * TT + idxc[(b * NE + z) * CAPC + (mc % CAPC)]; }
            return base + (size_t)r * ld;
        }
        return base + z * zstride + (size_t)m * ld;
    }
};

template <bool DUAL, class EF>
__global__ void __launch_bounds__(256) k_gemm(ALoad af, const float* W, const float* W2, int ldw, size_t wz, int M, int N, int K, EF ef) {
    __shared__ float As[8][128]; __shared__ float Bs[8][128]; __shared__ float Bs2[DUAL ? 8 : 1][128];
    const int z = blockIdx.z, tid = threadIdx.x, m0 = blockIdx.y * 128, n0 = blockIdx.x * 128, tx = tid & 15, ty = tid >> 4;
    W += z * wz; if (DUAL) W2 += z * wz;
    float acc[8][8], acc2[DUAL ? 8 : 1][8];
#pragma unroll
    for (int i = 0; i < 8; ++i)
#pragma unroll
        for (int j = 0; j < 8; ++j) { acc[i][j] = 0.f; if (DUAL) acc2[i][j] = 0.f; }
    const int arow = tid >> 1, ak = (tid & 1) * 4;
    const bf16_t* ap = (m0 + arow < M) ? af.rowptr(z, m0 + arow) : nullptr;
    const int bk = tid >> 5, bn = (tid & 31) * 4;
    const bool bok = (n0 + bn) < N;
    for (int k0 = 0; k0 < K; k0 += 8) {
        float av[4] = {0.f, 0.f, 0.f, 0.f};
        if (ap) { const ushort4 u = *(const ushort4*)(ap + k0 + ak); av[0] = bf2f(u.x); av[1] = bf2f(u.y); av[2] = bf2f(u.z); av[3] = bf2f(u.w); }
        float4 bv = make_float4(0.f, 0.f, 0.f, 0.f), bv2 = bv;
        if (bok) { bv = *(const float4*)(W + (size_t)(k0 + bk) * ldw + n0 + bn); if (DUAL) bv2 = *(const float4*)(W2 + (size_t)(k0 + bk) * ldw + n0 + bn); }
        __syncthreads();
#pragma unroll
        for (int j = 0; j < 4; ++j) As[ak + j][arow] = av[j];
        *(float4*)&Bs[bk][bn] = bv; if (DUAL) *(float4*)&Bs2[bk][bn] = bv2;
        __syncthreads();
#pragma unroll
        for (int kk = 0; kk < 8; ++kk) {
            const float4 a0 = *(const float4*)&As[kk][ty * 8], a1 = *(const float4*)&As[kk][ty * 8 + 4];
            const float4 c0 = *(const float4*)&Bs[kk][tx * 8], c1 = *(const float4*)&Bs[kk][tx * 8 + 4];
            const float a[8] = {a0.x, a0.y, a0.z, a0.w, a1.x, a1.y, a1.z, a1.w}, bb[8] = {c0.x, c0.y, c0.z, c0.w, c1.x, c1.y, c1.z, c1.w};
            float b2[8] = {0.f, 0.f, 0.f, 0.f, 0.f, 0.f, 0.f, 0.f};
            if (DUAL) { const float4 e0 = *(const float4*)&Bs2[kk][tx * 8], e1 = *(const float4*)&Bs2[kk][tx * 8 + 4]; b2[0] = e0.x; b2[1] = e0.y; b2[2] = e0.z; b2[3] = e0.w; b2[4] = e1.x; b2[5] = e1.y; b2[6] = e1.z; b2[7] = e1.w; }
#pragma unroll
            for (int i = 0; i < 8; ++i)
#pragma unroll
                for (int j = 0; j < 8; ++j) { acc[i][j] += a[i] * bb[j]; if (DUAL) acc2[i][j] += a[i] * b2[j]; }
        }
    }
#pragma unroll
    for (int i = 0; i < 8; ++i) { const int m = m0 + ty * 8 + i; if (m >= M) continue;
#pragma unroll
        for (int j = 0; j < 8; ++j) { const int n = n0 + tx * 8 + j; if (n < N) ef(z, m, n, acc[i][j], DUAL ? acc2[i][j] : 0.f); } }
}

struct EpiStore { bf16_t* out; int ld; size_t zstride; DI void operator()(int z, int m, int n, float v, float) const { out[z * zstride + (size_t)m * ld + n] = f2bf(v); } };
struct EpiQ { bf16_t* Q; DI void operator()(int, int m, int n, float v, float) const { const int b = m / TT, t = m % TT, h = n / 96, dd = n % 96; Q[((size_t)(b * 8 + h) * TT + t) * 96 + dd] = f2bf(v); } };
struct EpiKV { bf16_t* K; bf16_t* Vt; DI void operator()(int, int m, int n, float v, float) const {
    const int b = m / TT, t = m % TT, h = n >> 7, w = n & 127;
    if (w < 64) K[((size_t)(b * 8 + h) * TT + t) * 96 + w] = f2bf(v); else Vt[((size_t)(b * 8 + h) * 64 + (w - 64)) * TT + vperm(t)] = f2bf(v); } };
struct EpiRes { const float* xlat_in; const float* xctx_in; float* xlat_out; float* xctx_out; const float* MODl; int gIdx; int lat_only;
    DI void operator()(int, int m, int n, float v, float) const {
        const int b = m / TT, t = m % TT;
        if (t < CTX) { if (lat_only) return; const size_t o = (size_t)(b * CTX + t) * D + n; xctx_out[o] = xctx_in[o] + MODl[2 * 6144 + gIdx * 1024 + n] * v; }
        else { const size_t o = ((size_t)b * SEQ + (t - CTX)) * D + n; xlat_out[o] = xlat_in[o] + MODl[b * 6144 + gIdx * 1024 + n] * v; } } };
struct EpiU { bf16_t* U; DI void operator()(int z, int m, int n, float v1, float v2) const { U[((size_t)z * ESLOTS + m) * FF + n] = f2bf(siluf(v1) * v2); } };
struct EpiScatter { float* xlat; float* xctx; const float* MODl; const int* idx; const int* idxc; const float* gate; const float* gatec;
    DI void operator()(int z, int m, int n, float v, float) const {
        if (m < 2 * CAP) { const int b = m / CAP, s = m % CAP, tok = idx[(b * NE + z) * CAP + s]; const float gt = gate[(b * NE + z) * CAP + s];
            atomicAdd(xlat + ((size_t)b * SEQ + tok) * D + n, MODl[b * 6144 + 5 * 1024 + n] * gt * v); }
        else { const int mc = m - 2 * CAP, b = mc / CAPC, s = mc % CAPC, tok = idxc[(b * NE + z) * CAPC + s]; const float gt = gatec[(b * NE + z) * CAPC + s];
            atomicAdd(xctx + (size_t)(b * CTX + tok) * D + n, MODl[2 * 6144 + 5 * 1024 + n] * gt * v); } } };
struct EpiLD { bf16_t* out; const float* w0; DI void operator()(int, int m, int n, float v, float) const {
    const float zz = -(w0[n] + v); const float sp = zz > 20.f ? zz : log1pf(expf(zz)); const float w = -sp - 0.5f; out[(size_t)m * 512 + n] = f2bf(-expf(w)); } };
struct EpiAA { bf16_t* out; const float* a0; DI void operator()(int, int m, int n, float v, float) const { out[(size_t)m * 512 + n] = f2bf(sigmoidf(a0[n] + v)); } };

template <int NC> __global__ void __launch_bounds__(256) k_rms_inplace(bf16_t* PROJ, int col0, const float* g) {
    const int r = blockIdx.x * 4 + (threadIdx.x >> 6), lane = threadIdx.x & 63;
    bf16_t* p = PROJ + (size_t)r * PLD + col0;
    float v[NC], ss = 0.f;
#pragma unroll
    for (int j = 0; j < NC; ++j) { v[j] = bf2f(p[lane + 64 * j]); ss += v[j] * v[j]; }
    ss = wave_sum(ss);
    const float rstd = rsqrtf(ss / (64.f * NC) + 1e-6f);
#pragma unroll
    for (int j = 0; j < NC; ++j) p[lane + 64 * j] = f2bf(v[j] * rstd * g[lane + 64 * j]);
}
DI float rope_freq(int i, int half) { return powf(10000.f, -(float)i / (float)half); }
DI void rot(float& x1, float& x2, float ang) { float s, c; sincosf(ang, &s, &c); const float a = x1 * c - x2 * s, b = x1 * s + x2 * c; x1 = a; x2 = b; }

__global__ void __launch_bounds__(256) k_rope_q(bf16_t* Q, float scq) {
    const int id = blockIdx.x * 256 + threadIdx.x; if (id >= MT * 8) return;
    const int r = id >> 3, h = id & 7, b = r / TT, t = r % TT;
    bf16_t* q = Q + ((size_t)(b * 8 + h) * TT + t) * 96;
    float v[96];
#pragma unroll
    for (int i = 0; i < 96; ++i) v[i] = bf2f(q[i]);
    if (t >= CTX) { const int n = t - CTX, row = n >> 6, col = n & 63;
#pragma unroll
        for (int i = 0; i < 8; ++i) { const float f = rope_freq(i, 8); rot(v[64 + i], v[72 + i], (float)row * f); rot(v[80 + i], v[88 + i], (float)col * f); } }
#pragma unroll
    for (int i = 0; i < 96; ++i) q[i] = f2bf(v[i] * scq);
}
__global__ void __launch_bounds__(256) k_rope_kr(const bf16_t* PROJ, bf16_t* K) {
    const int r = blockIdx.x * 256 + threadIdx.x; if (r >= MT) return;
    const int b = r / TT, t = r % TT;
    float v[32];
#pragma unroll
    for (int i = 0; i < 32; ++i) v[i] = bf2f(PROJ[(size_t)r * PLD + C_KR + i]);
    if (t >= CTX) { const int n = t - CTX, row = n >> 6, col = n & 63;
#pragma unroll
        for (int i = 0; i < 8; ++i) { const float f = rope_freq(i, 8); rot(v[i], v[8 + i], (float)row * f); rot(v[16 + i], v[24 + i], (float)col * f); } }
    for (int h = 0; h < 8; ++h) { bf16_t* k = K + ((size_t)(b * 8 + h) * TT + t) * 96 + 64;
#pragma unroll
        for (int i = 0; i < 32; ++i) k[i] = f2bf(v[i]); }
}
__global__ void __launch_bounds__(256) k_rope_ret(bf16_t* PROJ) {
    const size_t id = (size_t)blockIdx.x * 256 + threadIdx.x; if (id >= (size_t)MT * 256) return;
    const int r = (int)(id >> 8), h = (int)(id >> 6) & 3, i = (int)id & 63, t = r % TT;
    const float ang = (float)t * rope_freq(i, 64);
    float s, c; sincosf(ang, &s, &c);
    bf16_t* q = PROJ + (size_t)r * PLD + C_RQ + h * 128; bf16_t* k = PROJ + (size_t)r * PLD + C_RK + h * 128;
    const float q1 = bf2f(q[i]), q2 = bf2f(q[i + 64]), k1 = bf2f(k[i]), k2 = bf2f(k[i + 64]);
    const float ks = 0.08838834764831845f;
    q[i] = f2bf(q1 * c - q2 * s); q[i + 64] = f2bf(q1 * s + q2 * c);
    k[i] = f2bf((k1 * c - k2 * s) * ks); k[i + 64] = f2bf((k1 * s + k2 * c) * ks);
}

template <int DQK, int DV, int MODE>
__global__ void __launch_bounds__(128) k_attn(const bf16_t* Q, const bf16_t* K, const bf16_t* Vt, const float* sink, bf16_t* MIX, int col0) {
    __shared__ float Ks[64][DQK]; __shared__ float Vs[64][DV];
    const int qt = blockIdx.x, h = blockIdx.y, b = blockIdx.z, tid = threadIdx.x;
    const int HQ = 8, HKV = (MODE == 0) ? 8 : 2, hk = (MODE == 0) ? h : (h >> 2);
    const int QT = (MODE == 0) ? TT : SEQ;
    const int qpos = qt * 128 + tid;
    float qv[DQK], o[DV];
    const bf16_t* qp = Q + ((size_t)(b * HQ + h) * QT + qpos) * DQK;
#pragma unroll
    for (int i = 0; i < DQK; ++i) qv[i] = bf2f(qp[i]);
#pragma unroll
    for (int i = 0; i < DV; ++i) o[i] = 0.f;
    float m = -1e30f, l = 0.f;
    if (MODE == 1) { m = sink[h] * 1.4426950408889634f; l = 1.f; }
    int r0a = 0, r0b = CTX, r1a = 0, r1b = 0;
    if (MODE == 0) { if (qt >= 2) r0b = TT; }
    else { r1a = CTX + qt * 128 - 128; r1b = CTX + qt * 128 + 256; if (r1a < CTX) r1a = CTX; if (r1b > TT) r1b = TT; }
    const bf16_t* Kb = K + (size_t)(b * HKV + hk) * TT * DQK;
    const bf16_t* Vb = Vt + (size_t)(b * HKV + hk) * DV * TT;
    for (int rg = 0; rg < 2; ++rg) {
        const int ka = rg ? r1a : r0a, kb = rg ? r1b : r0b;
        for (int k0 = ka; k0 < kb; k0 += 64) {
            __syncthreads();
            for (int e = tid; e < 64 * DQK; e += 128) { const int j = e / DQK, d = e % DQK; Ks[j][d] = bf2f(Kb[(size_t)(k0 + j) * DQK + d]); }
            for (int e = tid; e < 64 * DV; e += 128) { const int d = e >> 6, j = e & 63; Vs[j][d] = bf2f(Vb[(size_t)d * TT + vperm(k0 + j)]); }
            __syncthreads();
            float s[64], mt = -1e30f;
#pragma unroll
            for (int j = 0; j < 64; ++j) {
                float a = 0.f;
#pragma unroll
                for (int d = 0; d < DQK; d += 4) { const float4 kk = *(const float4*)&Ks[j][d]; a += qv[d] * kk.x + qv[d + 1] * kk.y + qv[d + 2] * kk.z + qv[d + 3] * kk.w; }
                if (MODE == 1 && rg == 1) { const int dk = (k0 + j - CTX) - qpos; if (dk > 128 || dk < -128) a = -1e30f; }
                s[j] = a; mt = fmaxf(mt, a);
            }
            const float mn = fmaxf(m, mt), corr = exp2f(m - mn);
            l *= corr;
#pragma unroll
            for (int i = 0; i < DV; ++i) o[i] *= corr;
            m = mn;
#pragma unroll
            for (int j = 0; j < 64; ++j) {
                const float p = exp2f(s[j] - mn); l += p;
#pragma unroll
                for (int d = 0; d < DV; d += 4) { const float4 vv = *(const float4*)&Vs[j][d]; o[d] += p * vv.x; o[d + 1] += p * vv.y; o[d + 2] += p * vv.z; o[d + 3] += p * vv.w; }
            }
        }
    }
    const float inv = 1.f / l;
    const int r = (MODE == 0) ? b * TT + qpos : b * TT + CTX + qpos;
    bf16_t* op = MIX + (size_t)r * D + col0 + h * DV;
#pragma unroll
    for (int i = 0; i < DV; ++i) op[i] = f2bf(o[i] * inv);
}

DI float ret_gamma(int dir, int h) { return 1.f - exp2f(-(dir ? 5.5f : 5.0f) - (float)h); }
__global__ void __launch_bounds__(256) k_ret_kv(const bf16_t* PROJ, float* KVS) {
    __shared__ float ks[32][128]; __shared__ float vs[32][128]; __shared__ float pw[2][128];
    const int c = blockIdx.x, h = blockIdx.y, b = blockIdx.z, tid = threadIdx.x;
    const float lgf = log2f(ret_gamma(0, h)), lgb = log2f(ret_gamma(1, h));
    if (tid < 128) { pw[0][tid] = exp2f(lgf * (float)(127 - tid)); pw[1][tid] = exp2f(lgb * (float)tid); }
    float af[8][8], ab[8][8];
#pragma unroll
    for (int i = 0; i < 8; ++i)
#pragma unroll
        for (int j = 0; j < 8; ++j) { af[i][j] = 0.f; ab[i][j] = 0.f; }
    const int tv = (tid >> 4) * 8, td = (tid & 15) * 8;
    const size_t row0 = (size_t)b * TT + c * 128;
    for (int j0 = 0; j0 < 128; j0 += 32) {
        __syncthreads();
        for (int e = tid; e < 32 * 128; e += 256) { const int j = e >> 7, d = e & 127; const bf16_t* p = PROJ + (row0 + j0 + j) * PLD; ks[j][d] = bf2f(p[C_RK + h * 128 + d]); vs[j][d] = bf2f(p[C_RV + h * 128 + d]); }
        __syncthreads();
        for (int j = 0; j < 32; ++j) {
            const float df = pw[0][j0 + j], db = pw[1][j0 + j];
            float kv[8], vv[8];
#pragma unroll
            for (int i = 0; i < 8; ++i) { kv[i] = ks[j][td + i]; vv[i] = vs[j][tv + i]; }
#pragma unroll
            for (int i = 0; i < 8; ++i)
#pragma unroll
                for (int q = 0; q < 8; ++q) { const float x = vv[i] * kv[q]; af[i][q] += x * df; ab[i][q] += x * db; }
        }
    }
    float* of = KVS + ((((size_t)0 * 2 + b) * 4 + h) * 130 + c) * 16384, *ob = KVS + ((((size_t)1 * 2 + b) * 4 + h) * 130 + c) * 16384;
#pragma unroll
    for (int i = 0; i < 8; ++i)
#pragma unroll
        for (int q = 0; q < 8; ++q) { of[(tv + i) * 128 + td + q] = af[i][q]; ob[(tv + i) * 128 + td + q] = ab[i][q]; }
}
__global__ void __launch_bounds__(256) k_ret_scan(float* KVS) {
    const int id = blockIdx.x * 256 + threadIdx.x;
    const int e = id & 16383, h = (id >> 14) & 3, b = (id >> 16) & 1, dir = id >> 17;
    const float cd = exp2f(log2f(ret_gamma(dir, h)) * 128.f);
    float* base = KVS + (((size_t)dir * 2 + b) * 4 + h) * 130 * 16384 + e;
    float carry = 0.f;
    for (int s = 0; s < 130; ++s) {
        const int c = dir == 0 ? s : (s < 2 ? 1 - s : 131 - s);
        const float kv = base[(size_t)c * 16384];
        base[(size_t)c * 16384] = carry;
        carry = carry * cd + kv;
    }
}
__global__ void __launch_bounds__(256) k_ret_out(const bf16_t* PROJ, const float* KVS, const float* gn_g, bf16_t* MIX) {
    __shared__ float ks[32][128]; __shared__ float vs[32][128]; __shared__ float pw[2][130]; __shared__ float red[256];
    const int c = blockIdx.x, h = blockIdx.y, b = blockIdx.z, tid = threadIdx.x;
    const int i = tid >> 1, vh = (tid & 1) * 64;
    const float lgf = log2f(ret_gamma(0, h)), lgb = log2f(ret_gamma(1, h));
    if (tid < 130) { pw[0][tid] = exp2f(lgf * (float)tid); pw[1][tid] = exp2f(lgb * (float)tid); }
    const size_t row0 = (size_t)b * TT + c * 128;
    float q[128], o[64];
    { const bf16_t* qp = PROJ + (row0 + i) * PLD + C_RQ + h * 128;
#pragma unroll
      for (int d = 0; d < 128; ++d) q[d] = bf2f(qp[d]); }
#pragma unroll
    for (int v = 0; v < 64; ++v) o[v] = 0.f;
    for (int j0 = 0; j0 < 128; j0 += 32) {
        __syncthreads();
        for (int e = tid; e < 32 * 128; e += 256) { const int j = e >> 7, d = e & 127; const bf16_t* p = PROJ + (row0 + j0 + j) * PLD; ks[j][d] = bf2f(p[C_RK + h * 128 + d]); vs[j][d] = bf2f(p[C_RV + h * 128 + d]); }
        __syncthreads();
        for (int jj = 0; jj < 32; ++jj) {
            const int j = j0 + jj;
            float a = 0.f;
#pragma unroll
            for (int d = 0; d < 128; d += 4) { const float4 kk = *(const float4*)&ks[jj][d]; a += q[d] * kk.x + q[d + 1] * kk.y + q[d + 2] * kk.z + q[d + 3] * kk.w; }
            float w = 0.f;
            if (j <= i) w += pw[0][i - j];
            if (j >= i) w += pw[1][j - i];
            a *= w;
#pragma unroll
            for (int v = 0; v < 64; v += 4) { const float4 vv = *(const float4*)&vs[jj][vh + v]; o[v] += a * vv.x; o[v + 1] += a * vv.y; o[v + 2] += a * vv.z; o[v + 3] += a * vv.w; }
        }
    }
    for (int dir = 0; dir < 2; ++dir) {
        const float qd = dir == 0 ? pw[0][i + 1] : pw[1][128 - i];
        const float* St = KVS + ((((size_t)dir * 2 + b) * 4 + h) * 130 + c) * 16384;
        for (int v0 = 0; v0 < 128; v0 += 32) {
            __syncthreads();
            for (int e = tid; e < 32 * 128; e += 256) ks[e >> 7][e & 127] = St[(size_t)(v0 + (e >> 7)) * 128 + (e & 127)];
            __syncthreads();
            if (v0 >= vh && v0 < vh + 64) {
                for (int vv = 0; vv < 32; ++vv) {
                    float a = 0.f;
#pragma unroll
                    for (int d = 0; d < 128; d += 4) { const float4 kk = *(const float4*)&ks[vv][d]; a += q[d] * kk.x + q[d + 1] * kk.y + q[d + 2] * kk.z + q[d + 3] * kk.w; }
                    const int oi = v0 - vh + vv;
#pragma unroll
                    for (int x = 0; x < 64; ++x) if (x == oi) o[x] += qd * a;
                }
            }
        }
    }
    float s1 = 0.f;
#pragma unroll
    for (int v = 0; v < 64; ++v) s1 += o[v];
    __syncthreads(); red[tid] = s1; __syncthreads();
    const float mean = (red[tid] + red[tid ^ 1]) * (1.f / 128.f);
    float s2 = 0.f;
#pragma unroll
    for (int v = 0; v < 64; ++v) { o[v] -= mean; s2 += o[v] * o[v]; }
    __syncthreads(); red[tid] = s2; __syncthreads();
    const float rstd = rsqrtf((red[tid] + red[tid ^ 1]) * (1.f / 128.f) + 1e-5f);
    const bf16_t* gp = PROJ + (row0 + i) * PLD + C_RG + h * 128 + vh;
    bf16_t* op = MIX + (row0 + i) * D + 512 + h * 128 + vh;
#pragma unroll
    for (int v = 0; v < 64; ++v) { const float y = o[v] * rstd * gn_g[h * 128 + vh + v]; op[v] = f2bf(siluf(bf2f(gp[v])) * y); }
}

template <int N, int KSEL>
__global__ void __launch_bounds__(256) k_topk(const float* aff, int* idx_out, float* gate_out) {
    __shared__ unsigned hist[256]; __shared__ unsigned s_prefix, s_need; __shared__ unsigned scanA[256], scanB[256];
    const int p = blockIdx.x, tid = threadIdx.x;
    const float* a = aff + (size_t)p * N;
    unsigned prefix = 0, mask = 0, need = KSEL;
    for (int pass = 3; pass >= 0; --pass) {
        hist[tid] = 0; __syncthreads();
        for (int i = tid; i < N; i += 256) { const unsigned k = __float_as_uint(a[i]); if ((k & mask) == prefix) atomicAdd(&hist[(k >> (8 * pass)) & 255u], 1u); }
        __syncthreads();
        if (tid == 0) { unsigned cum = 0; int bin = 255; for (; bin > 0; --bin) { if (cum + hist[bin] >= need) break; cum += hist[bin]; } s_prefix = prefix | ((unsigned)bin << (8 * pass)); s_need = need - cum; }
        __syncthreads();
        prefix = s_prefix; need = s_need; mask |= 0xffu << (8 * pass);
        __syncthreads();
    }
    constexpr int PER = N / 256;
    unsigned gt = 0, eq = 0;
    for (int j = 0; j < PER; ++j) { const unsigned k = __float_as_uint(a[tid * PER + j]); gt += (k > prefix); eq += (k == prefix); }
    scanA[tid] = eq; __syncthreads();
    unsigned eqbase = 0; for (int j = 0; j < tid; ++j) eqbase += scanA[j];
    unsigned take = 0; if (eqbase < need) { take = need - eqbase; if (take > eq) take = eq; }
    scanB[tid] = gt + take; __syncthreads();
    unsigned pos = 0; for (int j = 0; j < tid; ++j) pos += scanB[j];
    unsigned eqc = 0;
    for (int j = 0; j < PER; ++j) { const int i = tid * PER + j; const float v = a[i]; const unsigned k = __float_as_uint(v);
        bool sel = k > prefix; if (k == prefix) { sel = eqc < take; ++eqc; }
        if (sel) { idx_out[(size_t)p * KSEL + pos] = i; gate_out[(size_t)p * KSEL + pos] = v; ++pos; } }
}

__global__ void __launch_bounds__(256) k_shift(const bf16_t* PROJ, const float* mu, bf16_t* FR, bf16_t* FK, bf16_t* FV, bf16_t* LIN) {
    const size_t id = (size_t)blockIdx.x * 256 + threadIdx.x; if (id >= (size_t)MT * 1920) return;
    const int r = (int)(id / 1920), c = (int)(id % 1920), t = r % TT;
    const float p = bf2f(PROJ[(size_t)r * PLD + c]);
    const bool first = (t == 0 || t == CTX), last = (t == CTX - 1 || t == TT - 1);
    const float pv = first ? 0.f : bf2f(PROJ[(size_t)(r - 1) * PLD + c]), nx = last ? 0.f : bf2f(PROJ[(size_t)(r + 1) * PLD + c]);
    const float ps = p + mu[c] * (0.5f * (pv + nx) - p);
    if (c < 512) FR[(size_t)r * 512 + c] = f2bf(ps);
    else if (c < 1024) FK[(size_t)r * 512 + c - 512] = f2bf(ps);
    else if (c < 1536) FV[(size_t)r * 512 + c - 1024] = f2bf(ps);
    else if (c < 1664) LIN[(size_t)r * 384 + c - 1536] = f2bf(tanhf(ps));
    else if (c < 1792) LIN[(size_t)r * 384 + c - 1536] = f2bf(ps);
    else LIN[(size_t)r * 384 + c - 1536] = f2bf(sigmoidf(ps));
}
__global__ void __launch_bounds__(256) k_kk(const bf16_t* FR, const bf16_t* FK, const float* k_k, const float* r_k, bf16_t* FKK, float* BC) {
    const int w = blockIdx.x * 4 + (threadIdx.x >> 6), lane = threadIdx.x & 63;
    const int r = w >> 3, h = w & 7, c = h * 64 + lane;
    const float k = bf2f(FK[(size_t)r * 512 + c]), rr = bf2f(FR[(size_t)r * 512 + c]);
    const float kk = k * k_k[c];
    const float ss = wave_sum(kk * kk);
    FKK[(size_t)r * 512 + c] = f2bf(kk * rsqrtf(ss + 1e-12f));
    const float bc = wave_sum(rr * k * r_k[c]);
    if (lane == 0) BC[(size_t)r * 8 + h] = bc;
}
__global__ void __launch_bounds__(256) k_rwkv_scan(const bf16_t* FR, const bf16_t* FK, const bf16_t* FV, const bf16_t* FKK, const bf16_t* FA0, const bf16_t* FA1,
                                                    const bf16_t* FL0, const bf16_t* FL1, const float* k_a, bf16_t* Y) {
    constexpr int T = 32;
    __shared__ float sdec[T][64], skey[T][64], snkk[T][64], sbb[T][64], sr[T][64], sv[T][64];
    const int h = blockIdx.x, b = blockIdx.y, dir = blockIdx.z, tid = threadIdx.x;
    const int v = tid >> 2, qq = (tid & 3) * 16;
    const bf16_t* FA = dir ? FA1 : FA0; const bf16_t* FL = dir ? FL1 : FL0;
    float S[16];
#pragma unroll
    for (int j = 0; j < 16; ++j) S[j] = 0.f;
    bf16_t* Yp = Y + ((size_t)(dir * 2 + b) * SEQ) * 512 + h * 64;
    for (int s0 = 0; s0 < TT; s0 += T) {
        __syncthreads();
        for (int e = tid; e < T * 64; e += 256) {
            const int s = e >> 6, j = e & 63, sg = s0 + s;
            const int t = dir == 0 ? sg : (sg < CTX ? CTX - 1 - sg : TT - 1 - (sg - CTX));
            const size_t o = ((size_t)b * TT + t) * 512 + h * 64 + j;
            const float k = bf2f(FK[o]), a = bf2f(FA[o]), kk = bf2f(FKK[o]);
            sdec[s][j] = expf(bf2f(FL[o])); skey[s][j] = k * (1.f + (a - 1.f) * k_a[h * 64 + j]); snkk[s][j] = -kk; sbb[s][j] = kk * a; sr[s][j] = bf2f(FR[o]); sv[s][j] = bf2f(FV[o]);
        }
        __syncthreads();
        for (int s = 0; s < T; ++s) {
            float sa = 0.f;
#pragma unroll
            for (int j = 0; j < 16; ++j) sa += S[j] * snkk[s][qq + j];
            sa += __shfl_xor(sa, 1); sa += __shfl_xor(sa, 2);
            const float vv = sv[s][v];
            float y = 0.f;
#pragma unroll
            for (int j = 0; j < 16; ++j) { S[j] = S[j] * sdec[s][qq + j] + sa * sbb[s][qq + j] + vv * skey[s][qq + j]; y += S[j] * sr[s][qq + j]; }
            y += __shfl_xor(y, 1); y += __shfl_xor(y, 2);
            const int sg = s0 + s;
            if (sg >= CTX && (tid & 3) == 0) { const int n = dir == 0 ? sg - CTX : SEQ - 1 - (sg - CTX); Yp[(size_t)n * 512 + v] = f2bf(y); }
        }
    }
}
__global__ void __launch_bounds__(256) k_rwkv_out(const bf16_t* Y, const bf16_t* FV, const bf16_t* FGT, const float* BC, const float* ln_g, const float* ln_b, bf16_t* MIX) {
    const int w = blockIdx.x * 4 + (threadIdx.x >> 6), lane = threadIdx.x & 63;
    const int rl = w >> 3, h = w & 7, b = rl / SEQ, n = rl % SEQ, c = h * 64 + lane;
    const size_t r = (size_t)b * TT + CTX + n;
    const float y = bf2f(Y[((size_t)(0 * 2 + b) * SEQ + n) * 512 + c]) + bf2f(Y[((size_t)(1 * 2 + b) * SEQ + n) * 512 + c]);
    const float mean = wave_sum(y) * (1.f / 64.f);
    const float yc = y - mean;
    const float var = wave_sum(yc * yc) * (1.f / 64.f);
    const float yn = yc * rsqrtf(var + 64e-5f) * ln_g[c] + ln_b[c];
    const float bonus = BC[r * 8 + h] * bf2f(FV[r * 512 + c]);
    MIX[r * D + c] = f2bf((yn + bonus) * bf2f(FGT[r * 512 + c]));
}
__global__ void __launch_bounds__(256) k_win_prep(const bf16_t* PROJ, bf16_t* Q2, bf16_t* K2, bf16_t* V2t, float scq) {
    const int id = blockIdx.x * 256 + threadIdx.x; if (id >= MT * 12) return;
    const int r = id / 12, hs = id % 12, b = r / TT, t = r % TT;
    if (hs < 8 && t < CTX) return;
    const int col = hs < 8 ? O_WQ + hs * 64 : (hs < 10 ? O_WK + (hs - 8) * 64 : O_WV + (hs - 10) * 64);
    float v[64];
#pragma unroll
    for (int i = 0; i < 64; ++i) v[i] = bf2f(PROJ[(size_t)r * PLD + col + i]);
    if (hs < 10 && t >= CTX) { const int n = t - CTX, row = n >> 6, cl = n & 63;
#pragma unroll
        for (int i = 0; i < 16; ++i) { const float f = rope_freq(i, 16); rot(v[i], v[16 + i], (float)row * f); rot(v[32 + i], v[48 + i], (float)cl * f); } }
    if (hs < 8) { bf16_t* q = Q2 + ((size_t)(b * 8 + hs) * SEQ + (t - CTX)) * 64;
#pragma unroll
        for (int i = 0; i < 64; ++i) q[i] = f2bf(v[i] * scq); }
    else if (hs < 10) { bf16_t* k = K2 + ((size_t)(b * 2 + hs - 8) * TT + t) * 64;
#pragma unroll
        for (int i = 0; i < 64; ++i) k[i] = f2bf(v[i]); }
    else { bf16_t* vt = V2t + (size_t)(b * 2 + hs - 10) * 64 * TT + vperm(t);
#pragma unroll
        for (int i = 0; i < 64; ++i) vt[(size_t)i * TT] = f2bf(v[i]); }
}
__global__ void __launch_bounds__(256) k_final(float* x, const float* g) {
    __shared__ float red[4];
    float* p = x + (size_t)blockIdx.x * D + threadIdx.x * 4;
    float4 v = *(float4*)p;
    const float ss = block_sum256(v.x * v.x + v.y * v.y + v.z * v.z + v.w * v.w, red);
    const float rstd = rsqrtf(ss * (1.f / 1024.f) + 1e-6f);
    const float4 gg = *(const float4*)(g + threadIdx.x * 4);
    v.x = v.x * rstd * gg.x; v.y = v.y * rstd * gg.y; v.z = v.z * rstd * gg.z; v.w = v.w * rstd * gg.w;
    *(float4*)p = v;
}

extern "C" void kernel_launch(void* const* d_in, const int* in_sizes, int n_in, void* d_out, int out_size, void* d_ws, size_t ws_size, hipStream_t st) {
    const float* x = (const float*)d_in[0]; const float* c = (const float*)d_in[1]; const float* ctx = (const float*)d_in[2]; const float* c_ctx = (const float*)d_in[3];
    const float* ada_w = (const float*)d_in[4]; const float* ada_b = (const float*)d_in[5]; const float* norm_mix_g = (const float*)d_in[6]; const float* norm_ffn_g = (const float*)d_in[7];
    const float* final_g = (const float*)d_in[8]; const float* ev_w_in = (const float*)d_in[9]; const float* ev_w_out = (const float*)d_in[10]; const float* q_norm_g = (const float*)d_in[11];
    const float* w_uq = (const float*)d_in[12]; const float* kv_norm_g = (const float*)d_in[13]; const float* w_ukv = (const float*)d_in[14]; const float* ret_norm_g = (const float*)d_in[15];
    const float* od_w_in = (const float*)d_in[16]; const float* od_w_out = (const float*)d_in[17]; const float* rwkv_mu = (const float*)d_in[18]; const float* rwkv_w0 = (const float*)d_in[19];
    const float* rwkv_w2 = (const float*)d_in[20]; const float* rwkv_a0 = (const float*)d_in[21]; const float* rwkv_a2 = (const float*)d_in[22]; const float* rwkv_g2 = (const float*)d_in[23];
    const float* rwkv_k_k = (const float*)d_in[24]; const float* rwkv_k_a = (const float*)d_in[25]; const float* rwkv_r_k = (const float*)d_in[26]; const float* rwkv_ln_g = (const float*)d_in[27];
    const float* rwkv_ln_b = (const float*)d_in[28]; const float* win_sink = (const float*)d_in[29]; const float* moe_router = (const float*)d_in[30]; const float* moe_w_gate = (const float*)d_in[31];
    const float* moe_w_up = (const float*)d_in[32]; const float* moe_w_down = (const float*)d_in[33];
    float* out = (float*)d_out; char* ws = (char*)d_ws;
    if (ws_size < WS_END) return;
    float* MOD = (float*)(ws + OFF_MOD); float* XCTX = (float*)(ws + OFF_XCTX); float* AFF = (float*)(ws + OFF_AFF); float* AFFC = (float*)(ws + OFF_AFFC);
    int* IDX = (int*)(ws + OFF_IDX); float* GATE = (float*)(ws + OFF_GATE); int* IDXC = (int*)(ws + OFF_IDXC); float* GATEC = (float*)(ws + OFF_GATEC); float* BC = (float*)(ws + OFF_BC);
    bf16_t* ABUF = (bf16_t*)(ws + OFF_ABUF); bf16_t* PROJ = (bf16_t*)(ws + OFF_PROJ);
    bf16_t* Q = (bf16_t*)(ws + OFF_Q); bf16_t* K = (bf16_t*)(ws + OFF_K); bf16_t* VT = (bf16_t*)(ws + OFF_VT); float* KVS = (float*)(ws + OFF_KVS); bf16_t* U = (bf16_t*)(ws + OFF_U);
    bf16_t* FR = (bf16_t*)(ws + OFF_FR); bf16_t* FK = (bf16_t*)(ws + OFF_FK); bf16_t* FV = (bf16_t*)(ws + OFF_FV); bf16_t* FKK = (bf16_t*)(ws + OFF_FKK);
    bf16_t* FA0 = (bf16_t*)(ws + OFF_FA0); bf16_t* FA1 = (bf16_t*)(ws + OFF_FA1); bf16_t* FL0 = (bf16_t*)(ws + OFF_FL0); bf16_t* FL1 = (bf16_t*)(ws + OFF_FL1);
    bf16_t* FGT = (bf16_t*)(ws + OFF_FGT); bf16_t* LIN = (bf16_t*)(ws + OFF_LIN); bf16_t* Y = (bf16_t*)(ws + OFF_Y);
    bf16_t* Q2 = (bf16_t*)(ws + OFF_Q2); bf16_t* K2 = (bf16_t*)(ws + OFF_K2); bf16_t* V2T = (bf16_t*)(ws + OFF_V2T);
    const float LOG2E = 1.4426950408889634f;

    k_mod<<<dim3(24, 2), 256, 0, st>>>(c, c_ctx, ada_w, ada_b, MOD);
    {
        const float* MODl = MOD;
        k_norm_mod<<<MT, 256, 0, st>>>(x, ctx, norm_mix_g, MODl, 0, ABUF, nullptr, nullptr, nullptr, 0);
        { ALoad a{ABUF, D, 0, nullptr, nullptr, 0, 0}; EpiStore e{PROJ, PLD, 0};
          k_gemm<false, EpiStore><<<dim3((EVEN_IN + 127) / 128, MT / 128, 1), 256, 0, st>>>(a, ev_w_in, nullptr, EVEN_IN, 0, MT, EVEN_IN, D, e); }
        k_rms_inplace<4><<<MT / 4, 256, 0, st>>>(PROJ, C_CQ, q_norm_g);
        k_rms_inplace<2><<<MT / 4, 256, 0, st>>>(PROJ, C_CKV, kv_norm_g);
        { ALoad a{PROJ, PLD, 0, nullptr, nullptr, 0, C_CQ}; EpiQ e{Q};
          k_gemm<false, EpiQ><<<dim3(768 / 128, MT / 128, 1), 256, 0, st>>>(a, w_uq, nullptr, 768, 0, MT, 768, 256, e); }
        { ALoad a{PROJ, PLD, 0, nullptr, nullptr, 0, C_CKV}; EpiKV e{K, VT};
          k_gemm<false, EpiKV><<<dim3(1024 / 128, MT / 128, 1), 256, 0, st>>>(a, w_ukv, nullptr, 1024, 0, MT, 1024, 128, e); }
        k_rope_q<<<(MT * 8 + 255) / 256, 256, 0, st>>>(Q, 0.10206207261596577f * LOG2E);
        k_rope_kr<<<(MT + 255) / 256, 256, 0, st>>>(PROJ, K);
        k_rope_ret<<<(unsigned)(((size_t)MT * 256 + 255) / 256), 256, 0, st>>>(PROJ);
        k_attn<96, 64, 0><<<dim3(TT / 128, 8, 2), 128, 0, st>>>(Q, K, VT, nullptr, ABUF, 0);
        k_ret_kv<<<dim3(130, 4, 2), 256, 0, st>>>(PROJ, KVS);
        k_ret_scan<<<(2 * 2 * 4 * 16384) / 256, 256, 0, st>>>(KVS);
        k_ret_out<<<dim3(130, 4, 2), 256, 0, st>>>(PROJ, KVS, ret_norm_g, ABUF);
        { ALoad a{ABUF, D, 0, nullptr, nullptr, 0, 0}; EpiRes e{x, ctx, out, XCTX, MODl, 2, 0};
          k_gemm<false, EpiRes><<<dim3(D / 128, MT / 128, 1), 256, 0, st>>>(a, ev_w_out, nullptr, D, 0, MT, D, D, e); }
        k_norm_mod<<<MT, 256, 0, st>>>(out, XCTX, norm_ffn_g, MODl, 3, ABUF, moe_router, AFF, AFFC, 0);
        k_topk<SEQ, CAP><<<32, 256, 0, st>>>(AFF, IDX, GATE);
        k_topk<CTX, CAPC><<<32, 256, 0, st>>>(AFFC, IDXC, GATEC);
        { ALoad a{ABUF, D, 1, IDX, IDXC, 0, 0}; EpiU e{U};
          k_gemm<true, EpiU><<<dim3(FF / 128, (ESLOTS + 127) / 128, NE), 256, 0, st>>>(a, moe_w_gate, moe_w_up, FF, (size_t)D * FF, ESLOTS, FF, D, e); }
        { ALoad a{U, FF, 2, nullptr, nullptr, (size_t)ESLOTS * FF, 0}; EpiScatter e{out, XCTX, MODl, IDX, IDXC, GATE, GATEC};
          k_gemm<false, EpiScatter><<<dim3(D / 128, (ESLOTS + 127) / 128, NE), 256, 0, st>>>(a, moe_w_down, nullptr, D, (size_t)FF * D, ESLOTS, D, FF, e); }
    }
    {
        const float* MODl = MOD + 3 * 6144;
        k_norm_mod<<<MT, 256, 0, st>>>(out, XCTX, norm_mix_g + D, MODl, 0, ABUF, nullptr, nullptr, nullptr, 0);
        { ALoad a{ABUF, D, 0, nullptr, nullptr, 0, 0}; EpiStore e{PROJ, PLD, 0};
          k_gemm<false, EpiStore><<<dim3(ODD_IN / 128, MT / 128, 1), 256, 0, st>>>(a, od_w_in, nullptr, ODD_IN, 0, MT, ODD_IN, D, e); }
        k_shift<<<(unsigned)(((size_t)MT * 1920 + 255) / 256), 256, 0, st>>>(PROJ, rwkv_mu, FR, FK, FV, LIN);
        for (int d = 0; d < 2; ++d) {
            { ALoad a{LIN, 384, 0, nullptr, nullptr, 0, 64 * d}; EpiLD e{d ? FL1 : FL0, rwkv_w0 + d * 512};
              k_gemm<false, EpiLD><<<dim3(4, MT / 128, 1), 256, 0, st>>>(a, rwkv_w2 + (size_t)d * 64 * 512, nullptr, 512, 0, MT, 512, 64, e); }
            { ALoad a{LIN, 384, 0, nullptr, nullptr, 0, 128 + 64 * d}; EpiAA e{d ? FA1 : FA0, rwkv_a0 + d * 512};
              k_gemm<false, EpiAA><<<dim3(4, MT / 128, 1), 256, 0, st>>>(a, rwkv_a2 + (size_t)d * 64 * 512, nullptr, 512, 0, MT, 512, 64, e); }
        }
        { ALoad a{LIN, 384, 0, nullptr, nullptr, 0, 256}; EpiStore e{FGT, 512, 0};
          k_gemm<false, EpiStore><<<dim3(4, MT / 128, 1), 256, 0, st>>>(a, rwkv_g2, nullptr, 512, 0, MT, 512, 128, e); }
        k_kk<<<MT * 8 / 4, 256, 0, st>>>(FR, FK, rwkv_k_k, rwkv_r_k, FKK, BC);
        k_rwkv_scan<<<dim3(8, 2, 2), 256, 0, st>>>(FR, FK, FV, FKK, FA0, FA1, FL0, FL1, rwkv_k_a, Y);
        k_rwkv_out<<<NB * SEQ * 8 / 4, 256, 0, st>>>(Y, FV, FGT, BC, rwkv_ln_g, rwkv_ln_b, ABUF);
        k_win_prep<<<(MT * 12 + 255) / 256, 256, 0, st>>>(PROJ, Q2, K2, V2T, 0.125f * LOG2E);
        k_attn<64, 64, 1><<<dim3(SEQ / 128, 8, 2), 128, 0, st>>>(Q2, K2, V2T, win_sink, ABUF, 512);
        { ALoad a{ABUF, D, 0, nullptr, nullptr, 0, 0}; EpiRes e{out, XCTX, out, XCTX, MODl, 2, 1};
          k_gemm<false, EpiRes><<<dim3(D / 128, MT / 128, 1), 256, 0, st>>>(a, od_w_out, nullptr, D, 0, MT, D, D, e); }
        k_norm_mod<<<MT, 256, 0, st>>>(out, XCTX, norm_ffn_g + D, MODl, 3, ABUF, moe_router + D * NE, AFF, AFFC, 1);
        k_topk<SEQ, CAP><<<32, 256, 0, st>>>(AFF, IDX, GATE);
        { ALoad a{ABUF, D, 1, IDX, IDXC, 0, 0}; EpiU e{U};
          k_gemm<true, EpiU><<<dim3(FF / 128, 2 * CAP / 128, NE), 256, 0, st>>>(a, moe_w_gate + (size_t)NE * D * FF, moe_w_up + (size_t)NE * D * FF, FF, (size_t)D * FF, 2 * CAP, FF, D, e); }
        { ALoad a{U, FF, 2, nullptr, nullptr, (size_t)ESLOTS * FF, 0}; EpiScatter e{out, XCTX, MODl, IDX, IDXC, GATE, GATEC};
          k_gemm<false, EpiScatter><<<dim3(D / 128, 2 * CAP / 128, NE), 256, 0, st>>>(a, moe_w_down + (size_t)NE * FF * D, nullptr, D, (size_t)FF * D, 2 * CAP, D, FF, e); }
        k_final<<<NB * SEQ, 256, 0, st>>>(out, final_g);
    }
}
```

```cpp
#include <hip/hip_runtime.h>
#include <stdint.h>

typedef unsigned short bf16_t;
#define DI __device__ __forceinline__

DI float bf2f(bf16_t v) { return __uint_as_float(((unsigned)v) << 16); }
DI bf16_t f2bf(float f) { unsigned u = __float_as_uint(f); u += 0x7fffu + ((u >> 16) & 1u); return (bf16_t)(u >> 16); }

constexpr int D = 1024, NB = 2, SEQ = 16384, CTX = 256, TT = SEQ + CTX  , MT = NB * TT  ;
constexpr int EVEN_IN = 2464, ODD_IN = 2688, PLD = 2688;
constexpr int NE = 16, FF = 1536, CAP = 2048, CAPC = 32, ESLOTS = 2 * CAP + 2 * CAPC  ;
constexpr int C_CQ = 0, C_CKV = 256, C_KR = 384, C_RQ = 416, C_RK = 928, C_RV = 1440, C_RG = 1952;
constexpr int O_R = 0, O_K = 512, O_V = 1024, O_WL = 1536, O_AL = 1664, O_GL = 1792, O_WQ = 1920, O_WK = 2432, O_WV = 2560;

constexpr size_t MB = 1u << 20;
constexpr size_t OFF_CTL = 0;
constexpr size_t OFF_MOD = 64u << 10;
constexpr size_t OFF_XCTX = 1 * MB;
constexpr size_t OFF_AFF = 3 * MB;
constexpr size_t OFF_AFFC = 5 * MB;
constexpr size_t OFF_IDX = 5 * MB + (64u << 10);
constexpr size_t OFF_GATE = OFF_IDX + (256u << 10);
constexpr size_t OFF_IDXC = OFF_GATE + (256u << 10);
constexpr size_t OFF_GATEC = OFF_IDXC + (4u << 10);
constexpr size_t OFF_BC = 6 * MB;
constexpr size_t OFF_WS = 8 * MB;
constexpr size_t OFF_ABUF = 24 * MB;
constexpr size_t OFF_PROJ = 89 * MB;
constexpr size_t OFF_ERA = 260 * MB;
constexpr size_t OFF_Q = OFF_ERA;
constexpr size_t OFF_K = OFF_ERA + 49 * MB;
constexpr size_t OFF_VT = OFF_ERA + 98 * MB;
constexpr size_t OFF_KVS = OFF_ERA + 131 * MB;
constexpr size_t OFF_U = OFF_ERA;
constexpr size_t FSZ = (size_t)MT * 512 * 2;
constexpr size_t OFF_FR = OFF_ERA, OFF_FK = OFF_FR + FSZ, OFF_FV = OFF_FK + FSZ, OFF_FKK = OFF_FV + FSZ, OFF_FA0 = OFF_FKK + FSZ, OFF_FA1 = OFF_FA0 + FSZ,
                 OFF_FL0 = OFF_FA1 + FSZ, OFF_FL1 = OFF_FL0 + FSZ, OFF_FGT = OFF_FL1 + FSZ, OFF_LIN = OFF_FGT + FSZ;
constexpr size_t OFF_Y = OFF_PROJ;
constexpr size_t OFF_Q2 = OFF_LIN + 25 * MB;
constexpr size_t OFF_K2 = OFF_Q2 + 32 * MB;
constexpr size_t OFF_V2T = OFF_K2 + 9 * MB;
static_assert(OFF_K2 + 18 * MB <= OFF_ERA + 366 * MB + 2 * MB, "L1 era");
constexpr size_t WS_END_NAIVE = OFF_V2T + 9 * MB;
constexpr size_t OFF_WMOE = OFF_ERA + 366 * MB;
constexpr size_t OFF_WD = OFF_WMOE + 96 * MB;
constexpr size_t WS_END = OFF_WMOE + 144 * MB;

DI int vperm(int t) { return (t & ~12) | ((t & 4) << 1) | ((t & 8) >> 1); }

DI float wave_sum(float v) {
#pragma unroll
    for (int o = 32; o > 0; o >>= 1) v += __shfl_xor(v, o);
    return v;
}
DI float block_sum256(float v, float* red) {
    v = wave_sum(v);
    __syncthreads();
    if ((threadIdx.x & 63) == 0) red[threadIdx.x >> 6] = v;
    __syncthreads();
    return red[0] + red[1] + red[2] + red[3];
}
DI float siluf(float x) { return x / (1.f + __expf(-x)); }
DI float sigmoidf(float x) { return 1.f / (1.f + __expf(-x)); }

__global__ void __launch_bounds__(256) k_mod(const float* c, const float* c_ctx, const float* ada_w, const float* ada_b, float* MOD) {
    __shared__ float sv[3][1024];
    const int layer = blockIdx.y, j = blockIdx.x * 256 + threadIdx.x;
    for (int i = threadIdx.x; i < 3072; i += 256) { int s = i >> 10, ii = i & 1023; float v = s < 2 ? c[s * 1024 + ii] : c_ctx[ii]; sv[s][ii] = v / (1.f + expf(-v)); }
    __syncthreads();
    const float* w = ada_w + (size_t)layer * 1024 * 6144 + j;
    float a0 = 0, a1 = 0, a2 = 0;
    for (int i = 0; i < 1024; ++i) { float ww = w[(size_t)i * 6144]; a0 += sv[0][i] * ww; a1 += sv[1][i] * ww; a2 += sv[2][i] * ww; }
    const float bb = ada_b[layer * 6144 + j];
    MOD[(layer * 3 + 0) * 6144 + j] = a0 + bb; MOD[(layer * 3 + 1) * 6144 + j] = a1 + bb; MOD[(layer * 3 + 2) * 6144 + j] = a2 + bb;
}

__global__ void __launch_bounds__(256) k_norm_mod(const float* xlat, const float* xctx, const float* g, const float* MODl, int shIdx, bf16_t* out,
                                                   const float* wr, float* AFF, float* AFFC, int lat_only) {
    __shared__ float red[4]; __shared__ float lg[4][16];
    const int r = blockIdx.x, b = r / TT, t = r % TT, tid = threadIdx.x;
    if (lat_only && t < CTX) return;
    const float* src = t < CTX ? xctx + (size_t)(b * CTX + t) * D : xlat + ((size_t)b * SEQ + (t - CTX)) * D;
    const int s = t < CTX ? 2 : b;
    const float4 xv = *(const float4*)(src + tid * 4);
    float ss = xv.x * xv.x + xv.y * xv.y + xv.z * xv.z + xv.w * xv.w;
    ss = block_sum256(ss, red);
    const float rstd = rsqrtf(ss * (1.f / 1024.f) + 1e-6f);
    const float* sh = MODl + s * 6144 + shIdx * 1024, *sc = sh + 1024;
    float xs[4] = {xv.x, xv.y, xv.z, xv.w}, h[4];
#pragma unroll
    for (int j = 0; j < 4; ++j) { const int i = tid * 4 + j; h[j] = (xs[j] * rstd * g[i]) * (1.f + sc[i]) + sh[i]; }
    ushort4 o; o.x = f2bf(h[0]); o.y = f2bf(h[1]); o.z = f2bf(h[2]); o.w = f2bf(h[3]);
    *(ushort4*)(out + (size_t)r * D + tid * 4) = o;
    if (wr) {
        float p[16];
#pragma unroll
        for (int e = 0; e < 16; ++e) p[e] = 0.f;
#pragma unroll
        for (int j = 0; j < 4; ++j) { const float* w = wr + (size_t)(tid * 4 + j) * 16;
#pragma unroll
            for (int e = 0; e < 16; ++e) p[e] += h[j] * w[e]; }
#pragma unroll
        for (int e = 0; e < 16; ++e) p[e] = wave_sum(p[e]);
        if ((tid & 63) == 0) {
#pragma unroll
            for (int e = 0; e < 16; ++e) lg[tid >> 6][e] = p[e]; }
        __syncthreads();
        if (tid < 16) {
            float l[16], m = -1e30f;
            for (int e = 0; e < 16; ++e) { l[e] = lg[0][e] + lg[1][e] + lg[2][e] + lg[3][e]; m = fmaxf(m, l[e]); }
            float sum = 0.f; for (int e = 0; e < 16; ++e) sum += expf(l[e] - m);
            const float a = expf(l[tid] - m) / sum;
            if (t < CTX) AFFC[(b * 16 + tid) * CTX + t] = a; else AFF[(size_t)(b * 16 + tid) * SEQ + (t - CTX)] = a;
        }
    }
}

struct ALoad {
    const bf16_t* base; int ld; int mode; const int* idx; const int* idxc; size_t zstride; int col0; int pad_;
    DI const bf16_t* rowptr(int z, int m) const {
        if (mode == 0) return base + (size_t)m * ld + col0;
        if (mode == 1) {
            int r;
            if (m < 2 * CAP) { const int b = m / CAP; r = b * TT + CTX + idx[(b * NE + z) * CAP + (m % CAP)]; }
            else { const int mc = m - 2 * CAP, b = mc / CAPC; r = b * TT + idxc[(b * NE + z) * CAPC + (mc % CAPC)]; }
            return base + (size_t)r * ld;
        }
        return base + z * zstride + (size_t)m * ld;
    }
};

template <bool DUAL, class EF>
__global__ void __launch_bounds__(256) k_gemm(ALoad af, const float* W, const float* W2, int ldw, size_t wz, int M, int N, int K, EF ef) {
    __shared__ float As[8][128]; __shared__ float Bs[8][128]; __shared__ float Bs2[DUAL ? 8 : 1][128];
    const int z = blockIdx.z, tid = threadIdx.x, m0 = blockIdx.y * 128, n0 = blockIdx.x * 128, tx = tid & 15, ty = tid >> 4;
    W += z * wz; if (DUAL) W2 += z * wz;
    float acc[8][8], acc2[DUAL ? 8 : 1][8];
#pragma unroll
    for (int i = 0; i < 8; ++i)
#pragma unroll
        for (int j = 0; j < 8; ++j) { acc[i][j] = 0.f; if (DUAL) acc2[i][j] = 0.f; }
    const int arow = tid >> 1, ak = (tid & 1) * 4;
    const bf16_t* ap = (m0 + arow < M) ? af.rowptr(z, m0 + arow) : nullptr;
    const int bk = tid >> 5, bn = (tid & 31) * 4;
    const bool bok = (n0 + bn) < N;
    for (int k0 = 0; k0 < K; k0 += 8) {
        float av[4] = {0.f, 0.f, 0.f, 0.f};
        if (ap) { const ushort4 u = *(const ushort4*)(ap + k0 + ak); av[0] = bf2f(u.x); av[1] = bf2f(u.y); av[2] = bf2f(u.z); av[3] = bf2f(u.w); }
        float4 bv = make_float4(0.f, 0.f, 0.f, 0.f), bv2 = bv;
        if (bok) { bv = *(const float4*)(W + (size_t)(k0 + bk) * ldw + n0 + bn); if (DUAL) bv2 = *(const float4*)(W2 + (size_t)(k0 + bk) * ldw + n0 + bn); }
        __syncthreads();
#pragma unroll
        for (int j = 0; j < 4; ++j) As[ak + j][arow] = av[j];
        *(float4*)&Bs[bk][bn] = bv; if (DUAL) *(float4*)&Bs2[bk][bn] = bv2;
        __syncthreads();
#pragma unroll
        for (int kk = 0; kk < 8; ++kk) {
            const float4 a0 = *(const float4*)&As[kk][ty * 8], a1 = *(const float4*)&As[kk][ty * 8 + 4];
            const float4 c0 = *(const float4*)&Bs[kk][tx * 8], c1 = *(const float4*)&Bs[kk][tx * 8 + 4];
            const float a[8] = {a0.x, a0.y, a0.z, a0.w, a1.x, a1.y, a1.z, a1.w}, bb[8] = {c0.x, c0.y, c0.z, c0.w, c1.x, c1.y, c1.z, c1.w};
            float b2[8] = {0.f, 0.f, 0.f, 0.f, 0.f, 0.f, 0.f, 0.f};
            if (DUAL) { const float4 e0 = *(const float4*)&Bs2[kk][tx * 8], e1 = *(const float4*)&Bs2[kk][tx * 8 + 4]; b2[0] = e0.x; b2[1] = e0.y; b2[2] = e0.z; b2[3] = e0.w; b2[4] = e1.x; b2[5] = e1.y; b2[6] = e1.z; b2[7] = e1.w; }
#pragma unroll
            for (int i = 0; i < 8; ++i)
#pragma unroll
                for (int j = 0; j < 8; ++j) { acc[i][j] += a[i] * bb[j]; if (DUAL) acc2[i][j] += a[i] * b2[j]; }
        }
    }
#pragma unroll
    for (int i = 0; i < 8; ++i) { const int m = m0 + ty * 8 + i; if (m >= M) continue;
#pragma unroll
        for (int j = 0; j < 8; ++j) { const int n = n0 + tx * 8 + j; if (n < N) ef(z, m, n, acc[i][j], DUAL ? acc2[i][j] : 0.f); } }
}

struct EpiStore { bf16_t* out; int ld; int pad_; size_t zstride; DI void operator()(int z, int m, int n, float v, float) const { out[z * zstride + (size_t)m * ld + n] = f2bf(v); } };
struct EpiQ { bf16_t* Q; DI void operator()(int, int m, int n, float v, float) const { const int b = m / TT, t = m % TT, h = n / 96, dd = n % 96; Q[((size_t)(b * 8 + h) * TT + t) * 96 + dd] = f2bf(v); } };
struct EpiKV { bf16_t* K; bf16_t* Vt; DI void operator()(int, int m, int n, float v, float) const {
    const int b = m / TT, t = m % TT, h = n >> 7, w = n & 127;
    if (w < 64) K[((size_t)(b * 8 + h) * TT + t) * 96 + w] = f2bf(v); else Vt[((size_t)(b * 8 + h) * 64 + (w - 64)) * TT + vperm(t)] = f2bf(v); } };
struct EpiRes { const float* xlat_in; const float* xctx_in; float* xlat_out; float* xctx_out; const float* MODl; int gIdx; int lat_only;
    DI void operator()(int, int m, int n, float v, float) const {
        const int b = m / TT, t = m % TT;
        if (t < CTX) { if (lat_only) return; const size_t o = (size_t)(b * CTX + t) * D + n; xctx_out[o] = xctx_in[o] + MODl[2 * 6144 + gIdx * 1024 + n] * v; }
        else { const size_t o = ((size_t)b * SEQ + (t - CTX)) * D + n; xlat_out[o] = xlat_in[o] + MODl[b * 6144 + gIdx * 1024 + n] * v; } } };
struct EpiU { bf16_t* U; DI void operator()(int z, int m, int n, float v1, float v2) const { U[((size_t)z * ESLOTS + m) * FF + n] = f2bf(siluf(v1) * v2); } };
struct EpiScatter { float* xlat; float* xctx; const float* MODl; const int* idx; const int* idxc; const float* gate; const float* gatec;
    DI void operator()(int z, int m, int n, float v, float) const {
        if (m < 2 * CAP) { const int b = m / CAP, s = m % CAP, tok = idx[(b * NE + z) * CAP + s]; const float gt = gate[(b * NE + z) * CAP + s];
            atomicAdd(xlat + ((size_t)b * SEQ + tok) * D + n, MODl[b * 6144 + 5 * 1024 + n] * gt * v); }
        else { const int mc = m - 2 * CAP, b = mc / CAPC, s = mc % CAPC, tok = idxc[(b * NE + z) * CAPC + s]; const float gt = gatec[(b * NE + z) * CAPC + s];
            atomicAdd(xctx + (size_t)(b * CTX + tok) * D + n, MODl[2 * 6144 + 5 * 1024 + n] * gt * v); } } };
struct EpiLD { bf16_t* out; const float* w0; DI void operator()(int, int m, int n, float v, float) const {
    const float zz = -(w0[n] + v); const float sp = zz > 20.f ? zz : log1pf(expf(zz)); const float w = -sp - 0.5f; out[(size_t)m * 512 + n] = f2bf(-expf(w)); } };
struct EpiAA { bf16_t* out; const float* a0; DI void operator()(int, int m, int n, float v, float) const { out[(size_t)m * 512 + n] = f2bf(sigmoidf(a0[n] + v)); } };

template <int NC> __global__ void __launch_bounds__(256) k_rms_inplace(bf16_t* PROJ, int col0, const float* g) {
    const int r = blockIdx.x * 4 + (threadIdx.x >> 6), lane = threadIdx.x & 63;
    bf16_t* p = PROJ + (size_t)r * PLD + col0;
    float v[NC], ss = 0.f;
#pragma unroll
    for (int j = 0; j < NC; ++j) { v[j] = bf2f(p[lane + 64 * j]); ss += v[j] * v[j]; }
    ss = wave_sum(ss);
    const float rstd = rsqrtf(ss / (64.f * NC) + 1e-6f);
#pragma unroll
    for (int j = 0; j < NC; ++j) p[lane + 64 * j] = f2bf(v[j] * rstd * g[lane + 64 * j]);
}
DI float rope_freq(int i, int half) { return powf(10000.f, -(float)i / (float)half); }
DI void rot(float& x1, float& x2, float ang) { float s, c; sincosf(ang, &s, &c); const float a = x1 * c - x2 * s, b = x1 * s + x2 * c; x1 = a; x2 = b; }

__global__ void __launch_bounds__(256) k_rope_q(bf16_t* Q, float scq) {
    const int id = blockIdx.x * 256 + threadIdx.x; if (id >= MT * 8) return;
    const int r = id >> 3, h = id & 7, b = r / TT, t = r % TT;
    bf16_t* q = Q + ((size_t)(b * 8 + h) * TT + t) * 96;
    float v[96];
#pragma unroll
    for (int i = 0; i < 96; ++i) v[i] = bf2f(q[i]);
    if (t >= CTX) { const int n = t - CTX, row = n >> 6, col = n & 63;
#pragma unroll
        for (int i = 0; i < 8; ++i) { const float f = rope_freq(i, 8); rot(v[64 + i], v[72 + i], (float)row * f); rot(v[80 + i], v[88 + i], (float)col * f); } }
#pragma unroll
    for (int i = 0; i < 96; ++i) q[i] = f2bf(v[i] * scq);
}
__global__ void __launch_bounds__(256) k_rope_kr(const bf16_t* PROJ, bf16_t* K) {
    const int r = blockIdx.x * 256 + threadIdx.x; if (r >= MT) return;
    const int b = r / TT, t = r % TT;
    float v[32];
#pragma unroll
    for (int i = 0; i < 32; ++i) v[i] = bf2f(PROJ[(size_t)r * PLD + C_KR + i]);
    if (t >= CTX) { const int n = t - CTX, row = n >> 6, col = n & 63;
#pragma unroll
        for (int i = 0; i < 8; ++i) { const float f = rope_freq(i, 8); rot(v[i], v[8 + i], (float)row * f); rot(v[16 + i], v[24 + i], (float)col * f); } }
    for (int h = 0; h < 8; ++h) { bf16_t* k = K + ((size_t)(b * 8 + h) * TT + t) * 96 + 64;
#pragma unroll
        for (int i = 0; i < 32; ++i) k[i] = f2bf(v[i]); }
}
__global__ void __launch_bounds__(256) k_rope_ret(bf16_t* PROJ) {
    const size_t id = (size_t)blockIdx.x * 256 + threadIdx.x; if (id >= (size_t)MT * 256) return;
    const int r = (int)(id >> 8), h = (int)(id >> 6) & 3, i = (int)id & 63, t = r % TT;
    const float ang = (float)t * rope_freq(i, 64);
    float s, c; sincosf(ang, &s, &c);
    bf16_t* q = PROJ + (size_t)r * PLD + C_RQ + h * 128; bf16_t* k = PROJ + (size_t)r * PLD + C_RK + h * 128;
    const float q1 = bf2f(q[i]), q2 = bf2f(q[i + 64]), k1 = bf2f(k[i]), k2 = bf2f(k[i + 64]);
    const float ks = 0.08838834764831845f;
    q[i] = f2bf(q1 * c - q2 * s); q[i + 64] = f2bf(q1 * s + q2 * c);
    k[i] = f2bf((k1 * c - k2 * s) * ks); k[i + 64] = f2bf((k1 * s + k2 * c) * ks);
}

template <int DQK, int DV, int MODE>
__global__ void __launch_bounds__(128) k_attn(const bf16_t* Q, const bf16_t* K, const bf16_t* Vt, const float* sink, bf16_t* MIX, int col0) {
    __shared__ float Ks[64][DQK]; __shared__ float Vs[64][DV];
    const int qt = blockIdx.x, h = blockIdx.y, b = blockIdx.z, tid = threadIdx.x;
    const int HQ = 8, HKV = (MODE == 0) ? 8 : 2, hk = (MODE == 0) ? h : (h >> 2);
    const int QT = (MODE == 0) ? TT : SEQ;
    const int qpos = qt * 128 + tid;
    float qv[DQK], o[DV];
    const bf16_t* qp = Q + ((size_t)(b * HQ + h) * QT + qpos) * DQK;
#pragma unroll
    for (int i = 0; i < DQK; ++i) qv[i] = bf2f(qp[i]);
#pragma unroll
    for (int i = 0; i < DV; ++i) o[i] = 0.f;
    float m = -1e30f, l = 0.f;
    if (MODE == 1) { m = sink[h] * 1.4426950408889634f; l = 1.f; }
    int r0a = 0, r0b = CTX, r1a = 0, r1b = 0;
    if (MODE == 0) { if (qt >= 2) r0b = TT; }
    else { r1a = CTX + qt * 128 - 128; r1b = CTX + qt * 128 + 256; if (r1a < CTX) r1a = CTX; if (r1b > TT) r1b = TT; }
    const bf16_t* Kb = K + (size_t)(b * HKV + hk) * TT * DQK;
    const bf16_t* Vb = Vt + (size_t)(b * HKV + hk) * DV * TT;
    for (int rg = 0; rg < 2; ++rg) {
        const int ka = rg ? r1a : r0a, kb = rg ? r1b : r0b;
        for (int k0 = ka; k0 < kb; k0 += 64) {
            __syncthreads();
            for (int e = tid; e < 64 * DQK; e += 128) { const int j = e / DQK, d = e % DQK; Ks[j][d] = bf2f(Kb[(size_t)(k0 + j) * DQK + d]); }
            for (int e = tid; e < 64 * DV; e += 128) { const int d = e >> 6, j = e & 63; Vs[j][d] = bf2f(Vb[(size_t)d * TT + vperm(k0 + j)]); }
            __syncthreads();
            float s[64], mt = -1e30f;
#pragma unroll
            for (int j = 0; j < 64; ++j) {
                float a = 0.f;
#pragma unroll
                for (int d = 0; d < DQK; d += 4) { const float4 kk = *(const float4*)&Ks[j][d]; a += qv[d] * kk.x + qv[d + 1] * kk.y + qv[d + 2] * kk.z + qv[d + 3] * kk.w; }
                if (MODE == 1 && rg == 1) { const int dk = (k0 + j - CTX) - qpos; if (dk > 128 || dk < -128) a = -1e30f; }
                s[j] = a; mt = fmaxf(mt, a);
            }
            const float mn = fmaxf(m, mt), corr = exp2f(m - mn);
            l *= corr;
#pragma unroll
            for (int i = 0; i < DV; ++i) o[i] *= corr;
            m = mn;
#pragma unroll
            for (int j = 0; j < 64; ++j) {
                const float p = exp2f(s[j] - mn); l += p;
#pragma unroll
                for (int d = 0; d < DV; d += 4) { const float4 vv = *(const float4*)&Vs[j][d]; o[d] += p * vv.x; o[d + 1] += p * vv.y; o[d + 2] += p * vv.z; o[d + 3] += p * vv.w; }
            }
        }
    }
    const float inv = 1.f / l;
    const int r = (MODE == 0) ? b * TT + qpos : b * TT + CTX + qpos;
    bf16_t* op = MIX + (size_t)r * D + col0 + h * DV;
#pragma unroll
    for (int i = 0; i < DV; ++i) op[i] = f2bf(o[i] * inv);
}

DI float ret_gamma(int dir, int h) { return 1.f - exp2f(-(dir ? 5.5f : 5.0f) - (float)h); }
__global__ void __launch_bounds__(256) k_ret_kv(const bf16_t* PROJ, float* KVS) {
    __shared__ float ks[32][128]; __shared__ float vs[32][128]; __shared__ float pw[2][128];
    const int c = blockIdx.x, h = blockIdx.y, b = blockIdx.z, tid = threadIdx.x;
    const float lgf = log2f(ret_gamma(0, h)), lgb = log2f(ret_gamma(1, h));
    if (tid < 128) { pw[0][tid] = exp2f(lgf * (float)(127 - tid)); pw[1][tid] = exp2f(lgb * (float)tid); }
    float af[8][8], ab[8][8];
#pragma unroll
    for (int i = 0; i < 8; ++i)
#pragma unroll
        for (int j = 0; j < 8; ++j) { af[i][j] = 0.f; ab[i][j] = 0.f; }
    const int tv = (tid >> 4) * 8, td = (tid & 15) * 8;
    const size_t row0 = (size_t)b * TT + c * 128;
    for (int j0 = 0; j0 < 128; j0 += 32) {
        __syncthreads();
        for (int e = tid; e < 32 * 128; e += 256) { const int j = e >> 7, d = e & 127; const bf16_t* p = PROJ + (row0 + j0 + j) * PLD; ks[j][d] = bf2f(p[C_RK + h * 128 + d]); vs[j][d] = bf2f(p[C_RV + h * 128 + d]); }
        __syncthreads();
        for (int j = 0; j < 32; ++j) {
            const float df = pw[0][j0 + j], db = pw[1][j0 + j];
            float kv[8], vv[8];
#pragma unroll
            for (int i = 0; i < 8; ++i) { kv[i] = ks[j][td + i]; vv[i] = vs[j][tv + i]; }
#pragma unroll
            for (int i = 0; i < 8; ++i)
#pragma unroll
                for (int q = 0; q < 8; ++q) { const float x = vv[i] * kv[q]; af[i][q] += x * df; ab[i][q] += x * db; }
        }
    }
    float* of = KVS + ((((size_t)0 * 2 + b) * 4 + h) * 130 + c) * 16384, *ob = KVS + ((((size_t)1 * 2 + b) * 4 + h) * 130 + c) * 16384;
#pragma unroll
    for (int i = 0; i < 8; ++i)
#pragma unroll
        for (int q = 0; q < 8; ++q) { of[(tv + i) * 128 + td + q] = af[i][q]; ob[(tv + i) * 128 + td + q] = ab[i][q]; }
}
__global__ void __launch_bounds__(256) k_ret_scan(float* KVS) {
    const int id = blockIdx.x * 256 + threadIdx.x;
    const int e = id & 16383, h = (id >> 14) & 3, b = (id >> 16) & 1, dir = id >> 17;
    const float cd = exp2f(log2f(ret_gamma(dir, h)) * 128.f);
    float* base = KVS + (((size_t)dir * 2 + b) * 4 + h) * 130 * 16384 + e;
    float carry = 0.f;
    for (int s = 0; s < 130; ++s) {
        const int c = dir == 0 ? s : (s < 2 ? 1 - s : 131 - s);
        const float kv = base[(size_t)c * 16384];
        base[(size_t)c * 16384] = carry;
        carry = carry * cd + kv;
    }
}
__global__ void __launch_bounds__(256) k_ret_out(const bf16_t* PROJ, const float* KVS, const float* gn_g, bf16_t* MIX) {
    __shared__ float ks[32][128]; __shared__ float vs[32][128]; __shared__ float pw[2][130]; __shared__ float red[256];
    const int c = blockIdx.x, h = blockIdx.y, b = blockIdx.z, tid = threadIdx.x;
    const int i = tid >> 1, vh = (tid & 1) * 64;
    const float lgf = log2f(ret_gamma(0, h)), lgb = log2f(ret_gamma(1, h));
    if (tid < 130) { pw[0][tid] = exp2f(lgf * (float)tid); pw[1][tid] = exp2f(lgb * (float)tid); }
    const size_t row0 = (size_t)b * TT + c * 128;
    float q[128], o[64];
    { const bf16_t* qp = PROJ + (row0 + i) * PLD + C_RQ + h * 128;
#pragma unroll
      for (int d = 0; d < 128; ++d) q[d] = bf2f(qp[d]); }
#pragma unroll
    for (int v = 0; v < 64; ++v) o[v] = 0.f;
    for (int j0 = 0; j0 < 128; j0 += 32) {
        __syncthreads();
        for (int e = tid; e < 32 * 128; e += 256) { const int j = e >> 7, d = e & 127; const bf16_t* p = PROJ + (row0 + j0 + j) * PLD; ks[j][d] = bf2f(p[C_RK + h * 128 + d]); vs[j][d] = bf2f(p[C_RV + h * 128 + d]); }
        __syncthreads();
        for (int jj = 0; jj < 32; ++jj) {
            const int j = j0 + jj;
            float a = 0.f;
#pragma unroll
            for (int d = 0; d < 128; d += 4) { const float4 kk = *(const float4*)&ks[jj][d]; a += q[d] * kk.x + q[d + 1] * kk.y + q[d + 2] * kk.z + q[d + 3] * kk.w; }
            float w = 0.f;
            if (j <= i) w += pw[0][i - j];
            if (j >= i) w += pw[1][j - i];
            a *= w;
#pragma unroll
            for (int v = 0; v < 64; v += 4) { const float4 vv = *(const float4*)&vs[jj][vh + v]; o[v] += a * vv.x; o[v + 1] += a * vv.y; o[v + 2] += a * vv.z; o[v + 3] += a * vv.w; }
        }
    }
    for (int dir = 0; dir < 2; ++dir) {
        const float qd = dir == 0 ? pw[0][i + 1] : pw[1][128 - i];
        const float* St = KVS + ((((size_t)dir * 2 + b) * 4 + h) * 130 + c) * 16384;
        for (int v0 = 0; v0 < 128; v0 += 32) {
            __syncthreads();
            for (int e = tid; e < 32 * 128; e += 256) ks[e >> 7][e & 127] = St[(size_t)(v0 + (e >> 7)) * 128 + (e & 127)];
            __syncthreads();
            if (v0 >= vh && v0 < vh + 64) {
                for (int vv = 0; vv < 32; ++vv) {
                    float a = 0.f;
#pragma unroll
                    for (int d = 0; d < 128; d += 4) { const float4 kk = *(const float4*)&ks[vv][d]; a += q[d] * kk.x + q[d + 1] * kk.y + q[d + 2] * kk.z + q[d + 3] * kk.w; }
                    const int oi = v0 - vh + vv;
#pragma unroll
                    for (int x = 0; x < 64; ++x) if (x == oi) o[x] += qd * a;
                }
            }
        }
    }
    float s1 = 0.f;
#pragma unroll
    for (int v = 0; v < 64; ++v) s1 += o[v];
    __syncthreads(); red[tid] = s1; __syncthreads();
    const float mean = (red[tid] + red[tid ^ 1]) * (1.f / 128.f);
    float s2 = 0.f;
#pragma unroll
    for (int v = 0; v < 64; ++v) { o[v] -= mean; s2 += o[v] * o[v]; }
    __syncthreads(); red[tid] = s2; __syncthreads();
    const float rstd = rsqrtf((red[tid] + red[tid ^ 1]) * (1.f / 128.f) + 1e-5f);
    const bf16_t* gp = PROJ + (row0 + i) * PLD + C_RG + h * 128 + vh;
    bf16_t* op = MIX + (row0 + i) * D + 512 + h * 128 + vh;
#pragma unroll
    for (int v = 0; v < 64; ++v) { const float y = o[v] * rstd * gn_g[h * 128 + vh + v]; op[v] = f2bf(siluf(bf2f(gp[v])) * y); }
}

template <int N, int KSEL>
__global__ void __launch_bounds__(256) k_topk(const float* aff, int* idx_out, float* gate_out) {
    __shared__ unsigned hist[256]; __shared__ unsigned s_prefix, s_need; __shared__ unsigned scanA[256], scanB[256];
    const int p = blockIdx.x, tid = threadIdx.x;
    const float* a = aff + (size_t)p * N;
    unsigned prefix = 0, mask = 0, need = KSEL;
    for (int pass = 3; pass >= 0; --pass) {
        hist[tid] = 0; __syncthreads();
        for (int i = tid; i < N; i += 256) { const unsigned k = __float_as_uint(a[i]); if ((k & mask) == prefix) atomicAdd(&hist[(k >> (8 * pass)) & 255u], 1u); }
        __syncthreads();
        if (tid == 0) { unsigned cum = 0; int bin = 255; for (; bin > 0; --bin) { if (cum + hist[bin] >= need) break; cum += hist[bin]; } s_prefix = prefix | ((unsigned)bin << (8 * pass)); s_need = need - cum; }
        __syncthreads();
        prefix = s_prefix; need = s_need; mask |= 0xffu << (8 * pass);
        __syncthreads();
    }
    constexpr int PER = N / 256;
    unsigned gt = 0, eq = 0;
    for (int j = 0; j < PER; ++j) { const unsigned k = __float_as_uint(a[tid * PER + j]); gt += (k > prefix); eq += (k == prefix); }
    scanA[tid] = eq; __syncthreads();
    unsigned eqbase = 0; for (int j = 0; j < tid; ++j) eqbase += scanA[j];
    unsigned take = 0; if (eqbase < need) { take = need - eqbase; if (take > eq) take = eq; }
    scanB[tid] = gt + take; __syncthreads();
    unsigned pos = 0; for (int j = 0; j < tid; ++j) pos += scanB[j];
    unsigned eqc = 0;
    for (int j = 0; j < PER; ++j) { const int i = tid * PER + j; const float v = a[i]; const unsigned k = __float_as_uint(v);
        bool sel = k > prefix; if (k == prefix) { sel = eqc < take; ++eqc; }
        if (sel) { idx_out[(size_t)p * KSEL + pos] = i; gate_out[(size_t)p * KSEL + pos] = v; ++pos; } }
}

__global__ void __launch_bounds__(256) k_shift(const bf16_t* PROJ, const float* mu, bf16_t* FR, bf16_t* FK, bf16_t* FV, bf16_t* LIN) {
    const size_t id = (size_t)blockIdx.x * 256 + threadIdx.x; if (id >= (size_t)MT * 1920) return;
    const int r = (int)(id / 1920), c = (int)(id % 1920), t = r % TT;
    const float p = bf2f(PROJ[(size_t)r * PLD + c]);
    const bool first = (t == 0 || t == CTX), last = (t == CTX - 1 || t == TT - 1);
    const float pv = first ? 0.f : bf2f(PROJ[(size_t)(r - 1) * PLD + c]), nx = last ? 0.f : bf2f(PROJ[(size_t)(r + 1) * PLD + c]);
    const float ps = p + mu[c] * (0.5f * (pv + nx) - p);
    if (c < 512) FR[(size_t)r * 512 + c] = f2bf(ps);
    else if (c < 1024) FK[(size_t)r * 512 + c - 512] = f2bf(ps);
    else if (c < 1536) FV[(size_t)r * 512 + c - 1024] = f2bf(ps);
    else if (c < 1664) LIN[(size_t)r * 384 + c - 1536] = f2bf(tanhf(ps));
    else if (c < 1792) LIN[(size_t)r * 384 + c - 1536] = f2bf(ps);
    else LIN[(size_t)r * 384 + c - 1536] = f2bf(sigmoidf(ps));
}
__global__ void __launch_bounds__(256) k_kk(const bf16_t* FR, const bf16_t* FK, const float* k_k, const float* r_k, bf16_t* FKK, float* BC) {
    const int w = blockIdx.x * 4 + (threadIdx.x >> 6), lane = threadIdx.x & 63;
    const int r = w >> 3, h = w & 7, c = h * 64 + lane;
    const float k = bf2f(FK[(size_t)r * 512 + c]), rr = bf2f(FR[(size_t)r * 512 + c]);
    const float kk = k * k_k[c];
    const float ss = wave_sum(kk * kk);
    FKK[(size_t)r * 512 + c] = f2bf(kk * rsqrtf(ss + 1e-12f));
    const float bc = wave_sum(rr * k * r_k[c]);
    if (lane == 0) BC[(size_t)r * 8 + h] = bc;
}
__global__ void __launch_bounds__(256) k_rwkv_scan(const bf16_t* FR, const bf16_t* FK, const bf16_t* FV, const bf16_t* FKK, const bf16_t* FA0, const bf16_t* FA1,
                                                    const bf16_t* FL0, const bf16_t* FL1, const float* k_a, bf16_t* Y) {
    constexpr int T = 32;
    __shared__ float sdec[T][64], skey[T][64], snkk[T][64], sbb[T][64], sr[T][64], sv[T][64];
    const int h = blockIdx.x, b = blockIdx.y, dir = blockIdx.z, tid = threadIdx.x;
    const int v = tid >> 2, qq = (tid & 3) * 16;
    const bf16_t* FA = dir ? FA1 : FA0; const bf16_t* FL = dir ? FL1 : FL0;
    float S[16];
#pragma unroll
    for (int j = 0; j < 16; ++j) S[j] = 0.f;
    bf16_t* Yp = Y + ((size_t)(dir * 2 + b) * SEQ) * 512 + h * 64;
    for (int s0 = 0; s0 < TT; s0 += T) {
        __syncthreads();
        for (int e = tid; e < T * 64; e += 256) {
            const int s = e >> 6, j = e & 63, sg = s0 + s;
            const int t = dir == 0 ? sg : (sg < CTX ? CTX - 1 - sg : TT - 1 - (sg - CTX));
            const size_t o = ((size_t)b * TT + t) * 512 + h * 64 + j;
            const float k = bf2f(FK[o]), a = bf2f(FA[o]), kk = bf2f(FKK[o]);
            sdec[s][j] = expf(bf2f(FL[o])); skey[s][j] = k * (1.f + (a - 1.f) * k_a[h * 64 + j]); snkk[s][j] = -kk; sbb[s][j] = kk * a; sr[s][j] = bf2f(FR[o]); sv[s][j] = bf2f(FV[o]);
        }
        __syncthreads();
        for (int s = 0; s < T; ++s) {
            float sa = 0.f;
#pragma unroll
            for (int j = 0; j < 16; ++j) sa += S[j] * snkk[s][qq + j];
            sa += __shfl_xor(sa, 1); sa += __shfl_xor(sa, 2);
            const float vv = sv[s][v];
            float y = 0.f;
#pragma unroll
            for (int j = 0; j < 16; ++j) { S[j] = S[j] * sdec[s][qq + j] + sa * sbb[s][qq + j] + vv * skey[s][qq + j]; y += S[j] * sr[s][qq + j]; }
            y += __shfl_xor(y, 1); y += __shfl_xor(y, 2);
            const int sg = s0 + s;
            if (sg >= CTX && (tid & 3) == 0) { const int n = dir == 0 ? sg - CTX : SEQ - 1 - (sg - CTX); Yp[(size_t)n * 512 + v] = f2bf(y); }
        }
    }
}
__global__ void __launch_bounds__(256) k_rwkv_out(const bf16_t* Y, const bf16_t* FV, const bf16_t* FGT, const float* BC, const float* ln_g, const float* ln_b, bf16_t* MIX) {
    const int w = blockIdx.x * 4 + (threadIdx.x >> 6), lane = threadIdx.x & 63;
    const int rl = w >> 3, h = w & 7, b = rl / SEQ, n = rl % SEQ, c = h * 64 + lane;
    const size_t r = (size_t)b * TT + CTX + n;
    const float y = bf2f(Y[((size_t)(0 * 2 + b) * SEQ + n) * 512 + c]) + bf2f(Y[((size_t)(1 * 2 + b) * SEQ + n) * 512 + c]);
    const float mean = wave_sum(y) * (1.f / 64.f);
    const float yc = y - mean;
    const float var = wave_sum(yc * yc) * (1.f / 64.f);
    const float yn = yc * rsqrtf(var + 64e-5f) * ln_g[c] + ln_b[c];
    const float bonus = BC[r * 8 + h] * bf2f(FV[r * 512 + c]);
    MIX[r * D + c] = f2bf((yn + bonus) * bf2f(FGT[r * 512 + c]));
}
__global__ void __launch_bounds__(256) k_win_prep(const bf16_t* PROJ, bf16_t* Q2, bf16_t* K2, bf16_t* V2t, float scq) {
    const int id = blockIdx.x * 256 + threadIdx.x; if (id >= MT * 12) return;
    const int r = id / 12, hs = id % 12, b = r / TT, t = r % TT;
    if (hs < 8 && t < CTX) return;
    const int col = hs < 8 ? O_WQ + hs * 64 : (hs < 10 ? O_WK + (hs - 8) * 64 : O_WV + (hs - 10) * 64);
    float v[64];
#pragma unroll
    for (int i = 0; i < 64; ++i) v[i] = bf2f(PROJ[(size_t)r * PLD + col + i]);
    if (hs < 10 && t >= CTX) { const int n = t - CTX, row = n >> 6, cl = n & 63;
#pragma unroll
        for (int i = 0; i < 16; ++i) { const float f = rope_freq(i, 16); rot(v[i], v[16 + i], (float)row * f); rot(v[32 + i], v[48 + i], (float)cl * f); } }
    if (hs < 8) { bf16_t* q = Q2 + ((size_t)(b * 8 + hs) * SEQ + (t - CTX)) * 64;
#pragma unroll
        for (int i = 0; i < 64; ++i) q[i] = f2bf(v[i] * scq); }
    else if (hs < 10) { bf16_t* k = K2 + ((size_t)(b * 2 + hs - 8) * TT + t) * 64;
#pragma unroll
        for (int i = 0; i < 64; ++i) k[i] = f2bf(v[i]); }
    else { bf16_t* vt = V2t + (size_t)(b * 2 + hs - 10) * 64 * TT + vperm(t);
#pragma unroll
        for (int i = 0; i < 64; ++i) vt[(size_t)i * TT] = f2bf(v[i]); }
}
__global__ void __launch_bounds__(256) k_final(float* x, const float* g) {
    __shared__ float red[4];
    float* p = x + (size_t)blockIdx.x * D + threadIdx.x * 4;
    float4 v = *(float4*)p;
    const float ss = block_sum256(v.x * v.x + v.y * v.y + v.z * v.z + v.w * v.w, red);
    const float rstd = rsqrtf(ss * (1.f / 1024.f) + 1e-6f);
    const float4 gg = *(const float4*)(g + threadIdx.x * 4);
    v.x = v.x * rstd * gg.x; v.y = v.y * rstd * gg.y; v.z = v.z * rstd * gg.z; v.w = v.w * rstd * gg.w;
    *(float4*)p = v;
}


typedef short bf16x8 __attribute__((ext_vector_type(8)));
typedef float f32x16 __attribute__((ext_vector_type(16)));
typedef float f32x4 __attribute__((ext_vector_type(4)));
#define LAS __attribute__((address_space(3)))
#define MFMA32(a, b, c) __builtin_amdgcn_mfma_f32_32x32x16_bf16((a), (b), (c), 0, 0, 0)

#define XB_TMO      128
#define XB_XCNT(j)  (256  + 64 * (j))
#define XB_XSUB(j)  (1280 + 64 * (j))
#define XB_XGEN(j)  (2304 + 64 * (j))
#define XB_TOP      3328
#define XB_TOPGEN   3392
#define XCD_BAR_WORDS 3456
#define XB_SPIN_CAP (1u << 22)
DI unsigned xb_ld(unsigned* p)              { return __hip_atomic_load(p, __ATOMIC_RELAXED, __HIP_MEMORY_SCOPE_AGENT); }
DI unsigned xb_add(unsigned* p, unsigned v) { return __hip_atomic_fetch_add(p, v, __ATOMIC_RELAXED, __HIP_MEMORY_SCOPE_AGENT); }
DI unsigned xb_xcc_id() { return (unsigned)__builtin_amdgcn_s_getreg((3 << 11) | 20) & 0xFu; }
#define XB_SPIN(cond, bar) do { unsigned _sp = 0; while (cond) { __builtin_amdgcn_s_sleep(1); \
    if ((++_sp & 255u) == 0u) { if (xb_ld(&(bar)[XB_TMO])) break; if (_sp > XB_SPIN_CAP) { atomicAdd(&(bar)[XB_TMO], 1u); break; } } } } while (0)
struct XcdBarrier { unsigned* bar; unsigned x; volatile LAS unsigned* st; };
DI XcdBarrier xcd_barrier_post(unsigned* bar, volatile LAS unsigned* st) {
    XcdBarrier b; b.bar = bar; b.x = xb_xcc_id(); b.st = st;
    if (threadIdx.x == 0) (void)xb_add(&bar[XB_XCNT(b.x)], 1u);
    return b;
}
DI void xcd_barrier_complete(unsigned* bar, unsigned x, unsigned& nloc, unsigned& nx) {
    const unsigned G = gridDim.x * gridDim.y * gridDim.z;
    unsigned sum, cnt, mine, sp = 0u;
    for (;;) {
        sum = 0u; cnt = 0u; mine = 0u;
#pragma unroll
        for (unsigned j = 0; j < 16; ++j) { const unsigned c = xb_ld(&bar[XB_XCNT(j)]); sum += c; cnt += (c > 0u) ? 1u : 0u; mine = (j == x) ? c : mine; }
        if (sum == G) break;
        __builtin_amdgcn_s_sleep(1);
        if ((++sp & 255u) == 0u) { if (xb_ld(&bar[XB_TMO])) break; if (sp > XB_SPIN_CAP) { atomicAdd(&bar[XB_TMO], 1u); break; } }
    }
    nloc = mine > 0u ? mine : 1u; nx = cnt > 0u ? cnt : 1u;
}
DI void xcd_barrier(const XcdBarrier& b) {
    asm volatile("s_waitcnt vmcnt(0)" ::: "memory");
    __syncthreads();
    if (threadIdx.x == 0) {
        unsigned* bar = b.bar;
        __builtin_amdgcn_s_waitcnt(0);
        unsigned nloc = b.st[0], nx = b.st[1];
        if (nloc == 0u) { xcd_barrier_complete(bar, b.x, nloc, nx); b.st[0] = nloc; b.st[1] = nx; }
        const unsigned old = xb_add(&bar[XB_XSUB(b.x)], 1u);
        const unsigned gen = old / nloc;
        if (old + 1u == (gen + 1u) * nloc) {
            __builtin_amdgcn_fence(__ATOMIC_RELEASE, "agent");
            asm volatile("s_waitcnt vmcnt(0)" ::: "memory");
            const unsigned og = xb_add(&bar[XB_TOP], 1u);
            const unsigned tg = og / nx;
            if (og + 1u == (tg + 1u) * nx) xb_add(&bar[XB_TOPGEN], 1u);
            else XB_SPIN(xb_ld(&bar[XB_TOPGEN]) == tg, bar);
            __builtin_amdgcn_fence(__ATOMIC_ACQUIRE, "agent");
            xb_add(&bar[XB_XGEN(b.x)], 1u);
            asm volatile("s_waitcnt vmcnt(0)" ::: "memory");
        } else {
            XB_SPIN(xb_ld(&bar[XB_XGEN(b.x)]) == gen, bar);
            __builtin_amdgcn_fence(__ATOMIC_ACQUIRE, "agent");
            asm volatile("s_waitcnt vmcnt(0)" ::: "memory");
        }
    }
    __syncthreads();
}

struct ColId { DI int operator()(int n) const { return n; } };
template <class CM>
DI void conv_wt(char* smem, const float* W, int K, int N, bf16_t* Wt, const float* kgain, CM cm, int item, int nitems_stride, int& nitems_out) {
    float (*tl)[65] = (float (*)[65])smem;
    const int tk = K / 64, tn = (N + 63) / 64, tid = threadIdx.x;
    nitems_out = tk * tn;
    for (int it = item; it < tk * tn; it += nitems_stride) {
        const int k0 = (it % tk) * 64, n0 = (it / tk) * 64;
        __syncthreads();
        for (int e = tid; e < 4096; e += 256) { const int k = e >> 6, n = e & 63; float v = (n0 + n < N) ? W[(size_t)(k0 + k) * N + n0 + n] : 0.f; if (kgain) v *= kgain[k0 + k]; tl[k][n] = v; }
        __syncthreads();
        for (int e = tid; e < 4096; e += 256) { const int n = e >> 6, k = e & 63; if (n0 + n < N) Wt[(size_t)cm(n0 + n) * K + k0 + k] = f2bf(tl[k][n]); }
    }
}

constexpr int GEMM_LDS = 65536;
struct ARowsPlain { const bf16_t* base; int ld; DI const bf16_t* row(int m) const { return base + (size_t)m * ld; } };
template <bool TR, class AR, class EF>
DI void gemm_tile(char* smem, const AR& ar, int M, const bf16_t* Bt, int ldb, int K, int m0, int n0, EF& ef) {
    const int tid = threadIdx.x, lane = tid & 63, wv = __builtin_amdgcn_readfirstlane(tid >> 6), wr = wv >> 1, wc = wv & 1, l31 = lane & 31, hh = lane >> 5;
    const bf16_t* asrc[4]; const bf16_t* bsrc[4];
#pragma unroll
    for (int i = 0; i < 4; ++i) {
        const int row = i * 32 + wv * 8 + (lane >> 3), ch = (lane & 7) ^ ((row >> 1) & 7);
        int m = m0 + row; if (m >= M) m = M - 1;
        asrc[i] = ar.row(m) + ch * 8;
        bsrc[i] = Bt + (size_t)(n0 + row) * ldb + ch * 8;
    }
    f32x16 acc[2][2];
#pragma unroll
    for (int a = 0; a < 2; ++a)
#pragma unroll
        for (int b = 0; b < 2; ++b)
#pragma unroll
            for (int i = 0; i < 16; ++i) acc[a][b][i] = 0.f;
    auto stage = [&](int buf, int k0) {
#pragma unroll
        for (int i = 0; i < 4; ++i) {
            __builtin_amdgcn_global_load_lds((const unsigned*)(asrc[i] + k0), (LAS unsigned*)(smem + buf * 32768 + i * 4096 + wv * 1024), 16, 0, 0);
            __builtin_amdgcn_global_load_lds((const unsigned*)(bsrc[i] + k0), (LAS unsigned*)(smem + buf * 32768 + 16384 + i * 4096 + wv * 1024), 16, 0, 0);
        }
    };
    const int nk = K >> 6;
    __syncthreads();
    stage(0, 0);
    asm volatile("s_waitcnt vmcnt(0)" ::: "memory");
    __syncthreads();
    int arow[2], brow[2];
#pragma unroll
    for (int t = 0; t < 2; ++t) { arow[t] = wr * 64 + t * 32 + l31; brow[t] = wc * 64 + t * 32 + l31; }
    for (int t = 0; t < nk; ++t) {
        const int cur = t & 1;
        if (t + 1 < nk) stage(cur ^ 1, (t + 1) << 6);
        const char* Ab = smem + cur * 32768; const char* Bb = Ab + 16384;
#pragma unroll
        for (int ks = 0; ks < 4; ++ks) {
            bf16x8 af[2], bfr[2];
#pragma unroll
            for (int q = 0; q < 2; ++q) {
                af[q] = *(const bf16x8*)(Ab + arow[q] * 128 + (((ks * 2 + hh) ^ ((arow[q] >> 1) & 7)) << 4));
                bfr[q] = *(const bf16x8*)(Bb + brow[q] * 128 + (((ks * 2 + hh) ^ ((brow[q] >> 1) & 7)) << 4));
            }
#pragma unroll
            for (int a = 0; a < 2; ++a)
#pragma unroll
                for (int b = 0; b < 2; ++b) acc[a][b] = TR ? MFMA32(bfr[b], af[a], acc[a][b]) : MFMA32(af[a], bfr[b], acc[a][b]);
        }
        asm volatile("s_waitcnt vmcnt(0)" ::: "memory");
        __syncthreads();
    }
    if (TR) ef(m0 + wr * 64 + l31, n0 + wc * 64, hh, acc); else ef(m0 + wr * 64, n0 + wc * 64 + l31, hh, acc);
}
struct EpStoreBf16 { bf16_t* out; int ld; int M, N;
    DI void operator()(int m, int nb, int h, f32x16 (&acc)[2][2]) const {
#pragma unroll
        for (int mt = 0; mt < 2; ++mt) { const int mm = m + mt * 32; if (mm >= M) continue;
#pragma unroll
            for (int nt = 0; nt < 2; ++nt)
#pragma unroll
                for (int g = 0; g < 4; ++g) { const int n = nb + nt * 32 + 8 * g + 4 * h; if (n >= N) continue;
                    ushort4 o; o.x = f2bf(acc[mt][nt][4 * g]); o.y = f2bf(acc[mt][nt][4 * g + 1]); o.z = f2bf(acc[mt][nt][4 * g + 2]); o.w = f2bf(acc[mt][nt][4 * g + 3]);
                    *(ushort4*)(out + (size_t)mm * ld + n) = o; } } } };

DI ushort4 pack4(const f32x16& a, int g) { ushort4 o; o.x = f2bf(a[4 * g]); o.y = f2bf(a[4 * g + 1]); o.z = f2bf(a[4 * g + 2]); o.w = f2bf(a[4 * g + 3]); return o; }
#define EP_LOOP(M_) _Pragma("unroll") for (int mt = 0; mt < 2; ++mt) { const int mm = m + mt * 32; if (mm >= (M_)) continue; _Pragma("unroll") for (int nt = 0; nt < 2; ++nt) _Pragma("unroll") for (int g = 0; g < 4; ++g) { const int n = nb + nt * 32 + 8 * g + 4 * h;
#define EP_END } }
struct EpQraw { bf16_t* Q; DI void operator()(int m, int nb, int h, f32x16 (&acc)[2][2]) const {
    EP_LOOP(MT) const int b = mm / TT, t = mm % TT, hd = n / 96, dd = n % 96; *(ushort4*)(Q + ((size_t)(b * 8 + hd) * TT + t) * 96 + dd) = pack4(acc[mt][nt], g); EP_END } };
struct EpKVm { bf16_t* K; bf16_t* Vt; DI void operator()(int m, int nb, int h, f32x16 (&acc)[2][2]) const {
    EP_LOOP(MT) const int b = mm / TT, t = mm % TT, hd = n >> 7, w = n & 127;
        if (w < 64) *(ushort4*)(K + ((size_t)(b * 8 + hd) * TT + t) * 96 + w) = pack4(acc[mt][nt], g);
        else { bf16_t* vp = Vt + ((size_t)(b * 8 + hd) * 64 + (w - 64)) * TT + vperm(t);
#pragma unroll
            for (int j = 0; j < 4; ++j) vp[(size_t)j * TT] = f2bf(acc[mt][nt][4 * g + j]); } EP_END } };
struct EpResM { const float* xlat_in; const float* xctx_in; float* xlat_out; float* xctx_out; const float* MODl; int gIdx; int lat_only;
    DI void operator()(int m, int nb, int h, f32x16 (&acc)[2][2]) const {
        EP_LOOP(MT) const int b = mm / TT, t = mm % TT; const f32x16& a = acc[mt][nt];
            if (t < CTX) { if (!lat_only) { const size_t o = (size_t)(b * CTX + t) * D + n; const float4 xi = *(const float4*)(xctx_in + o); const float4 gg = *(const float4*)(MODl + 2 * 6144 + gIdx * 1024 + n);
                *(float4*)(xctx_out + o) = make_float4(xi.x + gg.x * a[4 * g], xi.y + gg.y * a[4 * g + 1], xi.z + gg.z * a[4 * g + 2], xi.w + gg.w * a[4 * g + 3]); } }
            else { const size_t o = ((size_t)b * SEQ + (t - CTX)) * D + n; const float4 xi = *(const float4*)(xlat_in + o); const float4 gg = *(const float4*)(MODl + b * 6144 + gIdx * 1024 + n);
                *(float4*)(xlat_out + o) = make_float4(xi.x + gg.x * a[4 * g], xi.y + gg.y * a[4 * g + 1], xi.z + gg.z * a[4 * g + 2], xi.w + gg.w * a[4 * g + 3]); } EP_END } };
struct EpLDm { bf16_t* out; const float* w0; DI void operator()(int m, int nb, int h, f32x16 (&acc)[2][2]) const {
    EP_LOOP(MT) ushort4 o; unsigned short* op = (unsigned short*)&o;
#pragma unroll
        for (int j = 0; j < 4; ++j) { const float zz = -(w0[n + j] + acc[mt][nt][4 * g + j]); const float sp = zz > 20.f ? zz : log1pf(expf(zz)); op[j] = f2bf(-expf(-sp - 0.5f)); }
        *(ushort4*)(out + (size_t)mm * 512 + n) = o; EP_END } };
struct EpAAm { bf16_t* out; const float* a0; DI void operator()(int m, int nb, int h, f32x16 (&acc)[2][2]) const {
    EP_LOOP(MT) ushort4 o; o.x = f2bf(sigmoidf(a0[n] + acc[mt][nt][4 * g])); o.y = f2bf(sigmoidf(a0[n + 1] + acc[mt][nt][4 * g + 1])); o.z = f2bf(sigmoidf(a0[n + 2] + acc[mt][nt][4 * g + 2])); o.w = f2bf(sigmoidf(a0[n + 3] + acc[mt][nt][4 * g + 3]));
        *(ushort4*)(out + (size_t)mm * 512 + n) = o; EP_END } };
struct EpUm { bf16_t* U; int Mv; DI void operator()(int m, int nb, int h, f32x16 (&acc)[2][2]) const {
#pragma unroll
    for (int mt = 0; mt < 2; ++mt) { const int mm = m + mt * 32; if (mm >= Mv) continue;
#pragma unroll
        for (int g = 0; g < 4; ++g) { const int n = (nb >> 1) + 8 * g + 4 * h; ushort4 o; unsigned short* op = (unsigned short*)&o;
#pragma unroll
            for (int j = 0; j < 4; ++j) op[j] = f2bf(siluf(acc[mt][0][4 * g + j]) * acc[mt][1][4 * g + j]);
            *(ushort4*)(U + (size_t)mm * FF + n) = o; } } } };
struct EpScatterM { float* xlat; float* xctx; const float* MODl; const int* idx; const int* idxc; const float* gate; const float* gatec; int e; int Mv;
    DI void operator()(int mb, int n, int h, f32x16 (&acc)[2][2]) const {
#pragma unroll
        for (int nt = 0; nt < 2; ++nt) { const int nn = n + nt * 32; const float g2l[3] = {MODl[0 * 6144 + 5 * 1024 + nn], MODl[1 * 6144 + 5 * 1024 + nn], MODl[2 * 6144 + 5 * 1024 + nn]};
#pragma unroll
            for (int mt = 0; mt < 2; ++mt)
#pragma unroll
                for (int r = 0; r < 16; ++r) { const int m = mb + mt * 32 + 8 * (r >> 2) + 4 * h + (r & 3); if (m >= Mv) continue;
                    if (m < 2 * CAP) { const int b = m / CAP, s = m % CAP, tok = idx[(b * NE + e) * CAP + s]; const float gt = gate[(b * NE + e) * CAP + s];
                        atomicAdd(xlat + ((size_t)b * SEQ + tok) * D + nn, (b ? g2l[1] : g2l[0]) * gt * acc[mt][nt][r]); }
                    else { const int mc = m - 2 * CAP, b = mc / CAPC, s = mc % CAPC, tok = idxc[(b * NE + e) * CAPC + s]; const float gt = gatec[(b * NE + e) * CAPC + s];
                        atomicAdd(xctx + (size_t)(b * CTX + tok) * D + nn, g2l[2] * gt * acc[mt][nt][r]); } } } } };
struct ARowsCol { const bf16_t* base; int ld; int col0; DI const bf16_t* row(int m) const { return base + (size_t)m * ld + col0; } };
struct ARowsMoe { const bf16_t* H; const int* idx; const int* idxc; int e;
    DI const bf16_t* row(int m) const { int r; if (m < 2 * CAP) { const int b = m / CAP; r = b * TT + CTX + idx[(b * NE + e) * CAP + (m % CAP)]; } else { const int mc = m - 2 * CAP, b = mc / CAPC; r = b * TT + idxc[(b * NE + e) * CAPC + (mc % CAPC)]; } return H + (size_t)r * D; } };
struct ColGate { DI int operator()(int n) const { return (n >> 5) * 64 + (n & 31); } };
struct ColUp { DI int operator()(int n) const { return (n >> 5) * 64 + 32 + (n & 31); } };


typedef __bf16 v2bf_t __attribute__((ext_vector_type(2)));
typedef float v2f_t __attribute__((ext_vector_type(2)));
typedef unsigned u32x4 __attribute__((ext_vector_type(4)));
DI unsigned pk_bf16(float a, float b) { v2f_t f = {a, b}; v2bf_t r = __builtin_convertvector(f, v2bf_t); return __builtin_bit_cast(unsigned, r); }
DI bf16x8 pack8(const f32x16& x, int s) { u32x4 p; p[0] = pk_bf16(x[8 * s], x[8 * s + 1]); p[1] = pk_bf16(x[8 * s + 2], x[8 * s + 3]); p[2] = pk_bf16(x[8 * s + 4], x[8 * s + 5]); p[3] = pk_bf16(x[8 * s + 6], x[8 * s + 7]); return __builtin_bit_cast(bf16x8, p); }
#define GLDS16(src, dst) __builtin_amdgcn_global_load_lds((const unsigned*)(src), (LAS unsigned*)(dst), 16, 0, 0)
constexpr int ATT_LDS = 2 * (64 * 96 * 2 + 8192);
template <int DQK, bool WINDOW>
DI void attn_block(char* smem, const bf16_t* Qg, const bf16_t* Kb, const bf16_t* Vtb, int ra0, int ra1, int rb0, int rb1, int qlat0, float sink_l2, bf16_t* outp) {
    constexpr int NKS = DQK / 16, KCH = DQK / 8, KROWB = DQK * 2, KTB = 64 * KROWB, STB = KTB + 8192, KR = KCH / 4;
    const int tid = threadIdx.x, lane = tid & 63, wv = __builtin_amdgcn_readfirstlane(tid >> 6), l31 = lane & 31, hh = lane >> 5;
    bf16x8 qf[NKS];
    { const bf16_t* qrow = Qg + (size_t)(wv * 32 + l31) * DQK + hh * 8;
#pragma unroll
      for (int ks = 0; ks < NKS; ++ks) qf[ks] = *(const bf16x8*)(qrow + ks * 16); }
    int koff[KR], voff[2];
#pragma unroll
    for (int i = 0; i < KR; ++i) { const int p = i * 256 + wv * 64 + lane, r = p / KCH, cp = p % KCH; const int c = (DQK == 96) ? (cp + 12 - ((r >> 2) & 3)) % 12 : (cp ^ ((r >> 1) & 7)); koff[i] = r * DQK + c * 8; }
#pragma unroll
    for (int i = 0; i < 2; ++i) { const int p = i * 256 + wv * 64 + lane, r = p >> 3, cp = p & 7; voff[i] = r * TT + ((cp ^ ((r >> 1) & 7)) << 3); }
    auto stage = [&](int buf, int key0) {
#pragma unroll
        for (int i = 0; i < KR; ++i) GLDS16(Kb + (size_t)key0 * DQK + koff[i], smem + buf * STB + i * 4096 + wv * 1024);
#pragma unroll
        for (int i = 0; i < 2; ++i) GLDS16(Vtb + key0 + voff[i], smem + buf * STB + KTB + i * 4096 + wv * 1024);
    };
    const int na = (ra1 - ra0) >> 6, nt = na + ((rb1 - rb0) >> 6);
    float m = WINDOW ? sink_l2 : -1e30f, l = (WINDOW && hh == 0) ? 1.f : 0.f;
    f32x16 o[2];
#pragma unroll
    for (int i = 0; i < 16; ++i) { o[0][i] = 0.f; o[1][i] = 0.f; }
    __syncthreads();
    stage(0, ra0 < ra1 ? ra0 : rb0);
    asm volatile("s_waitcnt vmcnt(0)" ::: "memory");
    __syncthreads();
    for (int ti = 0; ti < nt; ++ti) {
        const int cur = ti & 1, key0 = ti < na ? ra0 + (ti << 6) : rb0 + ((ti - na) << 6);
        if (ti + 1 < nt) { const int t1 = ti + 1; stage(cur ^ 1, t1 < na ? ra0 + (t1 << 6) : rb0 + ((t1 - na) << 6)); }
        const char* Kt = smem + cur * STB; const char* Vt = Kt + KTB;
        f32x16 s[2];
#pragma unroll
        for (int i = 0; i < 16; ++i) { s[0][i] = 0.f; s[1][i] = 0.f; }
#pragma unroll
        for (int kt = 0; kt < 2; ++kt) {
            const int kr = kt * 32 + l31; const char* kp = Kt + kr * KROWB; const int sw = (DQK == 96) ? ((kr >> 2) & 3) : ((kr >> 1) & 7);
#pragma unroll
            for (int ks = 0; ks < NKS; ++ks) { const int c = ks * 2 + hh; int cp; if (DQK == 96) { cp = c + sw; cp = cp >= 12 ? cp - 12 : cp; } else cp = c ^ sw;
                s[kt] = MFMA32(*(const bf16x8*)(kp + cp * 16), qf[ks], s[kt]); }
        }
        if (WINDOW && ti >= na) { const int qi = qlat0 + wv * 32 + l31;
#pragma unroll
            for (int kt = 0; kt < 2; ++kt)
#pragma unroll
                for (int r = 0; r < 16; ++r) { const int dk = (key0 - CTX + kt * 32 + 8 * (r >> 2) + 4 * hh + (r & 3)) - qi; if (dk > 128 || dk < -128) s[kt][r] = -1e30f; } }
        float mx = s[0][0];
#pragma unroll
        for (int r = 0; r < 16; ++r) mx = fmaxf(mx, fmaxf(s[0][r], s[1][r]));
        mx = fmaxf(mx, __shfl_xor(mx, 32));
        const float mn = fmaxf(m, mx), corr = __builtin_amdgcn_exp2f(m - mn); m = mn;
        l *= corr; o[0] *= corr; o[1] *= corr;
        float ps = 0.f;
#pragma unroll
        for (int kt = 0; kt < 2; ++kt)
#pragma unroll
            for (int r = 0; r < 16; ++r) { const float p = __builtin_amdgcn_exp2f(s[kt][r] - mn); ps += p; s[kt][r] = p; }
        l += ps;
        bf16x8 pb[4];
#pragma unroll
        for (int q = 0; q < 4; ++q) pb[q] = pack8(s[q >> 1], q & 1);
#pragma unroll
        for (int dvt = 0; dvt < 2; ++dvt) { const int vr = dvt * 32 + l31; const char* vp = Vt + vr * 128; const int sw = (vr >> 1) & 7;
#pragma unroll
            for (int s4 = 0; s4 < 4; ++s4) o[dvt] = MFMA32(*(const bf16x8*)(vp + (((s4 * 2 + hh) ^ sw) << 4)), pb[s4], o[dvt]); }
        asm volatile("s_waitcnt vmcnt(0)" ::: "memory");
        __syncthreads();
    }
    l += __shfl_xor(l, 32);
    const float inv = 1.f / l;
    bf16_t* op = outp + (size_t)(wv * 32 + l31) * D + 4 * hh;
#pragma unroll
    for (int dvt = 0; dvt < 2; ++dvt)
#pragma unroll
        for (int g = 0; g < 4; ++g) { uint2 w; w.x = pk_bf16(o[dvt][4 * g] * inv, o[dvt][4 * g + 1] * inv); w.y = pk_bf16(o[dvt][4 * g + 2] * inv, o[dvt][4 * g + 3] * inv); *(uint2*)(op + dvt * 32 + 8 * g) = w; }
}
DI void phase_mla_attn(char* smem, char* ws, int bid, int nb) {
    const bf16_t* Q = (const bf16_t*)(ws + OFF_Q); const bf16_t* K = (const bf16_t*)(ws + OFF_K); const bf16_t* VT = (const bf16_t*)(ws + OFF_VT); bf16_t* MIX = (bf16_t*)(ws + OFF_ABUF);
    if ((nb & 7) == 0) {
        const int x = bid & 7, sl = bid >> 3, G = nb >> 3;
        for (int J = sl; J < 256; J += G) { const int bh = x * 2 + (J >> 7), qt = J & 127, b = bh >> 3, h = bh & 7;
            attn_block<96, false>(smem, Q + ((size_t)bh * TT + CTX + qt * 128) * 96, K + (size_t)bh * TT * 96, VT + (size_t)bh * 64 * TT, 0, TT, 0, 0, 0, 0.f, MIX + ((size_t)b * TT + CTX + qt * 128) * D + h * 64); }
    } else {
        for (int J = bid; J < 2048; J += nb) { const int bh = J >> 7, qt = J & 127, b = bh >> 3, h = bh & 7;
            attn_block<96, false>(smem, Q + ((size_t)bh * TT + CTX + qt * 128) * 96, K + (size_t)bh * TT * 96, VT + (size_t)bh * 64 * TT, 0, TT, 0, 0, 0, 0.f, MIX + ((size_t)b * TT + CTX + qt * 128) * D + h * 64); }
    }
    for (int J = bid; J < 32; J += nb) { const int bh = J >> 1, ct = J & 1, b = bh >> 3, h = bh & 7;
        attn_block<96, false>(smem, Q + ((size_t)bh * TT + ct * 128) * 96, K + (size_t)bh * TT * 96, VT + (size_t)bh * 64 * TT, 0, CTX, 0, 0, 0, 0.f, MIX + ((size_t)b * TT + ct * 128) * D + h * 64); }
}
DI void phase_win_attn(char* smem, char* ws, const float* sink, int bid, int nb, int bid0) {
    const bf16_t* Q2 = (const bf16_t*)(ws + OFF_Q2); const bf16_t* K2 = (const bf16_t*)(ws + OFF_K2); const bf16_t* V2T = (const bf16_t*)(ws + OFF_V2T); bf16_t* MIX = (bf16_t*)(ws + OFF_ABUF);
    for (int J = bid - bid0; J < 2048; J += nb - bid0) { const int qt = J & 127, hq = (J >> 7) & 7, b = J >> 10, kvh = hq >> 2;
        int rb0 = CTX + qt * 128 - 128, rb1 = CTX + qt * 128 + 256; if (rb0 < CTX) rb0 = CTX; if (rb1 > TT) rb1 = TT;
        attn_block<64, true>(smem, Q2 + ((size_t)(b * 8 + hq) * SEQ + qt * 128) * 64, K2 + (size_t)(b * 2 + kvh) * TT * 64, V2T + (size_t)(b * 2 + kvh) * 64 * TT, 0, CTX, rb0, rb1, qt * 128,
                             sink[hq] * 1.4426950408889634f, MIX + ((size_t)b * TT + CTX + qt * 128) * D + 512 + hq * 64); }
}

constexpr size_t WS_EVIN = OFF_WS;
constexpr size_t WS_EVOUT = WS_EVIN + (size_t)2560 * 1024 * 2;
constexpr size_t WS_UQ = WS_EVOUT + (size_t)1024 * 1024 * 2;
constexpr size_t WS_UKV = WS_UQ + (size_t)768 * 256 * 2;
constexpr size_t WS_ODIN = WS_UKV + (size_t)1024 * 128 * 2;
constexpr size_t WS_ODOUT = WS_ODIN + (size_t)2688 * 1024 * 2;
constexpr size_t WS_W2 = WS_ODOUT + (size_t)1024 * 1024 * 2;
constexpr size_t WS_A2 = WS_W2 + (size_t)2 * 512 * 64 * 2;
constexpr size_t WS_G2 = WS_A2 + (size_t)2 * 512 * 64 * 2;
constexpr size_t WS_SMALL_END = WS_G2 + (size_t)512 * 128 * 2;
static_assert(WS_SMALL_END <= OFF_ABUF, "small weights overflow");

struct MArgs { const float* in[34]; float* out; char* ws; int ph_lo, ph_hi; };

DI void phase_mod(char* smem, const MArgs& a, int bid, int nb) {
    float (*sv)[1024] = (float (*)[1024])smem;
    const float* c = a.in[1]; const float* c_ctx = a.in[3]; const float* ada_w = a.in[4]; const float* ada_b = a.in[5]; float* MOD = (float*)(a.ws + OFF_MOD);
    for (int it = bid; it < 48; it += nb) {
        const int layer = it / 24, j = (it % 24) * 256 + threadIdx.x;
        __syncthreads();
        for (int i = threadIdx.x; i < 3072; i += 256) { int s = i >> 10, ii = i & 1023; float v = s < 2 ? c[s * 1024 + ii] : c_ctx[ii]; sv[s][ii] = v / (1.f + expf(-v)); }
        __syncthreads();
        const float* w = ada_w + (size_t)layer * 1024 * 6144 + j;
        float a0 = 0, a1 = 0, a2 = 0;
        for (int i = 0; i < 1024; ++i) { float ww = w[(size_t)i * 6144]; a0 += sv[0][i] * ww; a1 += sv[1][i] * ww; a2 += sv[2][i] * ww; }
        const float bb = ada_b[layer * 6144 + j];
        MOD[(layer * 3 + 0) * 6144 + j] = a0 + bb; MOD[(layer * 3 + 1) * 6144 + j] = a1 + bb; MOD[(layer * 3 + 2) * 6144 + j] = a2 + bb;
    }
}
template <bool ROUTER, bool LAT_ONLY>
DI void phase_norm_mod(const float* xlat, const float* xctx, const float* g, const float* MODl, int shIdx, bf16_t* out, const float* wr, float* AFF, float* AFFC, int bid, int nb) {
    const int lane = threadIdx.x & 63, wv = threadIdx.x >> 6;
    for (int r = bid * 4 + wv; r < MT; r += nb * 4) {
        const int b = r / TT, t = r % TT;
        if (LAT_ONLY && t < CTX) continue;
        const float* src = t < CTX ? xctx + (size_t)(b * CTX + t) * D : xlat + ((size_t)b * SEQ + (t - CTX)) * D;
        const int s = t < CTX ? 2 : b;
        float4 xv[4]; float ss = 0.f;
#pragma unroll
        for (int q = 0; q < 4; ++q) { xv[q] = *(const float4*)(src + q * 256 + lane * 4); ss += xv[q].x * xv[q].x + xv[q].y * xv[q].y + xv[q].z * xv[q].z + xv[q].w * xv[q].w; }
        ss = wave_sum(ss);
        const float rstd = rsqrtf(ss * (1.f / 1024.f) + 1e-6f);
        const float* sh = MODl + s * 6144 + shIdx * 1024, *sc = sh + 1024;
        float p[16];
        if (ROUTER) {
#pragma unroll
            for (int e = 0; e < 16; ++e) p[e] = 0.f; }
#pragma unroll
        for (int q = 0; q < 4; ++q) {
            const int i0 = q * 256 + lane * 4;
            const float4 gg = *(const float4*)(g + i0), s4 = *(const float4*)(sc + i0), h4 = *(const float4*)(sh + i0);
            float h[4];
            h[0] = (xv[q].x * rstd * gg.x) * (1.f + s4.x) + h4.x; h[1] = (xv[q].y * rstd * gg.y) * (1.f + s4.y) + h4.y;
            h[2] = (xv[q].z * rstd * gg.z) * (1.f + s4.z) + h4.z; h[3] = (xv[q].w * rstd * gg.w) * (1.f + s4.w) + h4.w;
            uint2 o; o.x = pk_bf16(h[0], h[1]); o.y = pk_bf16(h[2], h[3]);
            *(uint2*)(out + (size_t)r * D + i0) = o;
            if (ROUTER) {
#pragma unroll
                for (int j = 0; j < 4; ++j) { const float4* w4 = (const float4*)(wr + (size_t)(i0 + j) * 16);
#pragma unroll
                    for (int e4 = 0; e4 < 4; ++e4) { const float4 w = w4[e4]; p[e4 * 4] += h[j] * w.x; p[e4 * 4 + 1] += h[j] * w.y; p[e4 * 4 + 2] += h[j] * w.z; p[e4 * 4 + 3] += h[j] * w.w; } } }
        }
        if (ROUTER) {
            float mx = -1e30f;
#pragma unroll
            for (int e = 0; e < 16; ++e) { p[e] = wave_sum(p[e]); mx = fmaxf(mx, p[e]); }
            float sum = 0.f, mine = 0.f;
#pragma unroll
            for (int e = 0; e < 16; ++e) { const float ex = expf(p[e] - mx); sum += ex; if (e == lane) mine = ex; }
            if (lane < 16) { const float av = mine / sum; if (t < CTX) AFFC[(b * 16 + lane) * CTX + t] = av; else AFF[(size_t)(b * 16 + lane) * SEQ + (t - CTX)] = av; }
        }
    }
}
DI void phase_post0(const MArgs& a, int bid, int nb) {
    bf16_t* PROJ = (bf16_t*)(a.ws + OFF_PROJ); bf16_t* K = (bf16_t*)(a.ws + OFF_K);
    const float* qg = a.in[11]; const float* kvg = a.in[13];
    const int lane = threadIdx.x & 63, wv = threadIdx.x >> 6;
    for (int r = bid * 4 + wv; r < MT; r += nb * 4) {
        const int b = r / TT, t = r % TT;
        bf16_t* p = PROJ + (size_t)r * PLD;
        { float v[4], ss = 0.f;
#pragma unroll
          for (int j = 0; j < 4; ++j) { v[j] = bf2f(p[C_CQ + lane + 64 * j]); ss += v[j] * v[j]; }
          ss = wave_sum(ss); const float rstd = rsqrtf(ss * (1.f / 256.f) + 1e-6f);
#pragma unroll
          for (int j = 0; j < 4; ++j) p[C_CQ + lane + 64 * j] = f2bf(v[j] * rstd * qg[lane + 64 * j]); }
        { float v[2], ss = 0.f;
#pragma unroll
          for (int j = 0; j < 2; ++j) { v[j] = bf2f(p[C_CKV + lane + 64 * j]); ss += v[j] * v[j]; }
          ss = wave_sum(ss); const float rstd = rsqrtf(ss * (1.f / 128.f) + 1e-6f);
#pragma unroll
          for (int j = 0; j < 2; ++j) p[C_CKV + lane + 64 * j] = f2bf(v[j] * rstd * kvg[lane + 64 * j]); }
        {
          float x = bf2f(p[C_KR + (lane & 31)]);
          const float other = __shfl_xor(x, 8);
          if (t >= CTX) { const int n = t - CTX, dd = lane & 31, i = dd & 7, pos = (dd < 16) ? (n >> 6) : (n & 63);
              float sn, cs; sincosf((float)pos * rope_freq(i, 8), &sn, &cs);
              x = (dd & 8) ? (other * sn + x * cs) : (x * cs - other * sn); }
          if (lane < 32) { const bf16_t o = f2bf(x);
#pragma unroll
              for (int h = 0; h < 8; ++h) K[((size_t)(b * 8 + h) * TT + t) * 96 + 64 + lane] = o; } }
        { float sn, cs; sincosf((float)t * rope_freq(lane, 64), &sn, &cs);
          const float ks = 0.08838834764831845f;
#pragma unroll
          for (int h = 0; h < 4; ++h) { bf16_t* q = p + C_RQ + h * 128; bf16_t* k = p + C_RK + h * 128;
              const float q1 = bf2f(q[lane]), q2 = bf2f(q[lane + 64]), k1 = bf2f(k[lane]), k2 = bf2f(k[lane + 64]);
              q[lane] = f2bf(q1 * cs - q2 * sn); q[lane + 64] = f2bf(q1 * sn + q2 * cs);
              k[lane] = f2bf((k1 * cs - k2 * sn) * ks); k[lane + 64] = f2bf((k1 * sn + k2 * cs) * ks); } }
    }
}
struct EpQrope { bf16_t* Q; float scq;
    DI void operator()(int m, int nb, int h, f32x16 (&acc)[2][2]) const {
#pragma unroll
        for (int mt = 0; mt < 2; ++mt) { const int mm = m + mt * 32; const int b = mm / TT, t = mm % TT;
#pragma unroll
            for (int nt = 0; nt < 2; ++nt) { const int n0 = nb + nt * 32, hd = n0 / 96, dd0 = n0 % 96; f32x16 v = acc[mt][nt];
                if (dd0 == 64 && t >= CTX) { const int n = t - CTX, row = n >> 6, col = n & 63;
#pragma unroll
                    for (int j = 0; j < 4; ++j) { const float f = rope_freq(4 * h + j, 8); float sn, cs;
                        sincosf((float)row * f, &sn, &cs); { const float x1 = v[j], x2 = v[4 + j]; v[j] = x1 * cs - x2 * sn; v[4 + j] = x1 * sn + x2 * cs; }
                        sincosf((float)col * f, &sn, &cs); { const float x1 = v[8 + j], x2 = v[12 + j]; v[8 + j] = x1 * cs - x2 * sn; v[12 + j] = x1 * sn + x2 * cs; } } }
                bf16_t* qp = Q + ((size_t)(b * 8 + hd) * TT + t) * 96 + dd0 + 4 * h;
#pragma unroll
                for (int g = 0; g < 4; ++g) { uint2 w; w.x = pk_bf16(v[4 * g] * scq, v[4 * g + 1] * scq); w.y = pk_bf16(v[4 * g + 2] * scq, v[4 * g + 3] * scq); *(uint2*)(qp + 8 * g) = w; } } } } };

DI void ret_kv_item(char* smem, const bf16_t* PROJ, float* KVS, int c, int h, int b) {
    float (*ks)[128] = (float (*)[128])smem; float (*vs)[128] = (float (*)[128])(smem + 16384); float (*pw)[128] = (float (*)[128])(smem + 32768);
    int tid = threadIdx.x; asm volatile("" : "+v"(tid));
    const float lgf = log2f(ret_gamma(0, h)), lgb = log2f(ret_gamma(1, h));
    __syncthreads();
    if (tid < 128) { pw[0][tid] = exp2f(lgf * (float)(127 - tid)); pw[1][tid] = exp2f(lgb * (float)tid); }
    float af[8][8], ab[8][8];
#pragma unroll
    for (int i = 0; i < 8; ++i)
#pragma unroll
        for (int j = 0; j < 8; ++j) { af[i][j] = 0.f; ab[i][j] = 0.f; }
    const int tv = (tid >> 4) * 8, td = (tid & 15) * 8;
    const size_t row0 = (size_t)b * TT + c * 128;
    for (int j0 = 0; j0 < 128; j0 += 32) {
        __syncthreads();
        for (int e = tid; e < 32 * 128; e += 256) { const int j = e >> 7, d = e & 127; const bf16_t* p = PROJ + (row0 + j0 + j) * PLD; ks[j][d] = bf2f(p[C_RK + h * 128 + d]); vs[j][d] = bf2f(p[C_RV + h * 128 + d]); }
        __syncthreads();
        for (int j = 0; j < 32; ++j) {
            const float df = pw[0][j0 + j], db = pw[1][j0 + j];
            float kv[8], vv[8];
#pragma unroll
            for (int i = 0; i < 8; ++i) { kv[i] = ks[j][td + i]; vv[i] = vs[j][tv + i]; }
#pragma unroll
            for (int i = 0; i < 8; ++i)
#pragma unroll
                for (int q = 0; q < 8; ++q) { const float x = vv[i] * kv[q]; af[i][q] += x * df; ab[i][q] += x * db; }
        }
    }
    float* of = KVS + ((((size_t)0 * 2 + b) * 4 + h) * 130 + c) * 16384, *ob = KVS + ((((size_t)1 * 2 + b) * 4 + h) * 130 + c) * 16384;
#pragma unroll
    for (int i = 0; i < 8; ++i)
#pragma unroll
        for (int q = 0; q < 8; ++q) { of[(tv + i) * 128 + td + q] = af[i][q]; ob[(tv + i) * 128 + td + q] = ab[i][q]; }
}
DI void phase_ret_scan(float* KVS, int bid, int nb) {
    for (int id = bid * 256 + threadIdx.x; id < 2 * 2 * 4 * 16384; id += nb * 256) {
        const int e = id & 16383, h = (id >> 14) & 3, b = (id >> 16) & 1, dir = id >> 17;
        const float cd = exp2f(log2f(ret_gamma(dir, h)) * 128.f);
        float* base = KVS + (((size_t)dir * 2 + b) * 4 + h) * 130 * 16384 + e;
        float carry = 0.f;
        for (int s = 0; s < 130; ++s) {
            const int c = dir == 0 ? s : (s < 2 ? 1 - s : 131 - s);
            const float kv = base[(size_t)c * 16384];
            base[(size_t)c * 16384] = carry;
            carry = carry * cd + kv;
        }
    }
}
DI void ret_out_item(char* smem, const bf16_t* PROJ, const float* KVS, const float* gn_g, bf16_t* MIX, int c, int h, int b) {
    int tid = threadIdx.x; asm volatile("" : "+v"(tid));
    const int lane = tid & 63, wv = tid >> 6, l31 = lane & 31, hh = lane >> 5;
    const size_t row0 = (size_t)b * TT + c * 128;
    __syncthreads();
    for (int e = tid; e < 128 * 16; e += 256) { const int j = e >> 4, c8 = e & 15;
        const bf16x8 val = *(const bf16x8*)(PROJ + (row0 + j) * PLD + C_RV + h * 128 + c8 * 8);
        const int pos = vperm(j);
#pragma unroll
        for (int q = 0; q < 8; ++q) { const int v = c8 * 8 + q; *(short*)(smem + v * 256 + ((((pos >> 3) ^ (v & 15))) << 4) + (pos & 7) * 2) = val[q]; } }
    __syncthreads();
    const int i = wv * 32 + l31;
    bf16x8 qf[8];
    { const bf16_t* qrow = PROJ + (row0 + i) * PLD + C_RQ + h * 128 + hh * 8;
#pragma unroll
      for (int ks = 0; ks < 8; ++ks) qf[ks] = *(const bf16x8*)(qrow + ks * 16); }
    const float lgf = log2f(ret_gamma(0, h)), lgb = log2f(ret_gamma(1, h));
    bf16x8 pb[8];
#pragma unroll
    for (int jt = 0; jt < 4; ++jt) {
        f32x16 s;
#pragma unroll
        for (int r = 0; r < 16; ++r) s[r] = 0.f;
        const bf16_t* krow = PROJ + (row0 + jt * 32 + l31) * PLD + C_RK + h * 128 + hh * 8;
        asm volatile("" ::: "memory");
#pragma unroll
        for (int ks = 0; ks < 8; ++ks) s = MFMA32(*(const bf16x8*)(krow + ks * 16), qf[ks], s);
        asm volatile("" ::: "memory");
#pragma unroll
        for (int r = 0; r < 16; ++r) { const int j = jt * 32 + 8 * (r >> 2) + 4 * hh + (r & 3); const float d = (float)(i - j);
            const float w = (d >= 0.f ? __builtin_amdgcn_exp2f(lgf * d) : 0.f) + (d <= 0.f ? __builtin_amdgcn_exp2f(-lgb * d) : 0.f); s[r] *= w; }
        pb[2 * jt] = pack8(s, 0); pb[2 * jt + 1] = pack8(s, 1);
    }
    f32x16 o[4];
#pragma unroll
    for (int vt = 0; vt < 4; ++vt) {
#pragma unroll
        for (int r = 0; r < 16; ++r) o[vt][r] = 0.f;
        const int vr = vt * 32 + l31;
#pragma unroll
        for (int ks = 0; ks < 8; ++ks) o[vt] = MFMA32(*(const bf16x8*)(smem + vr * 256 + ((((ks * 2 + hh) ^ (vr & 15))) << 4)), pb[ks], o[vt]);
    }
#pragma unroll 1
    for (int dir = 0; dir < 2; ++dir) {
        const float* St = KVS + ((((size_t)dir * 2 + b) * 4 + h) * 130 + c) * 16384;
        const float qd = dir == 0 ? __builtin_amdgcn_exp2f(lgf * (float)(i + 1)) : __builtin_amdgcn_exp2f(lgb * (float)(128 - i));
#pragma unroll
        for (int vt = 0; vt < 4; ++vt) {
            f32x16 T;
#pragma unroll
            for (int r = 0; r < 16; ++r) T[r] = 0.f;
            const float* srow = St + (size_t)(vt * 32 + l31) * 128 + hh * 8;
            asm volatile("" ::: "memory");
#pragma unroll
            for (int ks = 0; ks < 8; ++ks) { const float4 x0 = *(const float4*)(srow + ks * 16), x1 = *(const float4*)(srow + ks * 16 + 4);
                u32x4 pk; pk[0] = pk_bf16(x0.x, x0.y); pk[1] = pk_bf16(x0.z, x0.w); pk[2] = pk_bf16(x1.x, x1.y); pk[3] = pk_bf16(x1.z, x1.w);
                T = MFMA32(__builtin_bit_cast(bf16x8, pk), qf[ks], T); }
            o[vt] += qd * T;
            __builtin_amdgcn_sched_barrier(0);
        }
    }
    float sm = 0.f;
#pragma unroll
    for (int vt = 0; vt < 4; ++vt)
#pragma unroll
        for (int r = 0; r < 16; ++r) sm += o[vt][r];
    sm += __shfl_xor(sm, 32);
    const float mean = sm * (1.f / 128.f);
    float sq = 0.f;
#pragma unroll
    for (int vt = 0; vt < 4; ++vt)
#pragma unroll
        for (int r = 0; r < 16; ++r) { o[vt][r] -= mean; sq += o[vt][r] * o[vt][r]; }
    sq += __shfl_xor(sq, 32);
    const float rstd = rsqrtf(sq * (1.f / 128.f) + 1e-5f);
    const bf16_t* gp = PROJ + (row0 + i) * PLD + C_RG + h * 128 + 4 * hh;
    bf16_t* op = MIX + (row0 + i) * D + 512 + h * 128 + 4 * hh;
    const float* gn = gn_g + h * 128 + 4 * hh;
#pragma unroll
    for (int vt = 0; vt < 4; ++vt)
#pragma unroll
        for (int g = 0; g < 4; ++g) { asm volatile("" ::: "memory"); const int v0 = vt * 32 + 8 * g; const ushort4 rg = *(const ushort4*)(gp + v0); const float4 gg = *(const float4*)(gn + v0);
            const float y0 = siluf(bf2f(rg.x)) * o[vt][4 * g] * rstd * gg.x, y1 = siluf(bf2f(rg.y)) * o[vt][4 * g + 1] * rstd * gg.y, y2 = siluf(bf2f(rg.z)) * o[vt][4 * g + 2] * rstd * gg.z, y3 = siluf(bf2f(rg.w)) * o[vt][4 * g + 3] * rstd * gg.w;
            uint2 w; w.x = pk_bf16(y0, y1); w.y = pk_bf16(y2, y3); *(uint2*)(op + v0) = w; }
}
template <int N, int KSEL>
DI void topk_item(char* smem, const float* aff, int* idx_out, float* gate_out, int p) {
    unsigned* hist = (unsigned*)smem; unsigned* scanA = hist + 256; unsigned* scanB = scanA + 256; unsigned* sh = scanB + 256;
    const int tid = threadIdx.x;
    const float* a = aff + (size_t)p * N;
    unsigned prefix = 0, mask = 0, need = KSEL;
    for (int pass = 3; pass >= 0; --pass) {
        __syncthreads();
        hist[tid] = 0; __syncthreads();
        for (int i = tid; i < N; i += 256) { const unsigned k = __float_as_uint(a[i]); if ((k & mask) == prefix) atomicAdd(&hist[(k >> (8 * pass)) & 255u], 1u); }
        __syncthreads();
        if (tid == 0) { unsigned cum = 0; int bin = 255; for (; bin > 0; --bin) { if (cum + hist[bin] >= need) break; cum += hist[bin]; } sh[0] = prefix | ((unsigned)bin << (8 * pass)); sh[1] = need - cum; }
        __syncthreads();
        prefix = sh[0]; need = sh[1]; mask |= 0xffu << (8 * pass);
    }
    constexpr int PER = N / 256;
    unsigned gt = 0, eq = 0;
    for (int j = 0; j < PER; ++j) { const unsigned k = __float_as_uint(a[tid * PER + j]); gt += (k > prefix); eq += (k == prefix); }
    __syncthreads();
    scanA[tid] = eq; __syncthreads();
    unsigned eqbase = 0; for (int j = 0; j < tid; ++j) eqbase += scanA[j];
    unsigned take = 0; if (eqbase < need) { take = need - eqbase; if (take > eq) take = eq; }
    scanB[tid] = gt + take; __syncthreads();
    unsigned pos = 0; for (int j = 0; j < tid; ++j) pos += scanB[j];
    unsigned eqc = 0;
    for (int j = 0; j < PER; ++j) { const int i = tid * PER + j; const float v = a[i]; const unsigned k = __float_as_uint(v);
        bool sel = k > prefix; if (k == prefix) { sel = eqc < take; ++eqc; }
        if (sel) { idx_out[(size_t)p * KSEL + pos] = i; gate_out[(size_t)p * KSEL + pos] = v; ++pos; } }
}
DI void phase_shift(const bf16_t* PROJ, const float* mu, bf16_t* FR, bf16_t* FK, bf16_t* FV, bf16_t* LIN, int bid, int nb) {
    for (size_t id = (size_t)bid * 256 + threadIdx.x; id < (size_t)MT * 480; id += (size_t)nb * 256) {
        const int r = (int)(id / 480), c = (int)(id % 480) * 4, t = r % TT;
        const bool first = (t == 0 || t == CTX), last = (t == CTX - 1 || t == TT - 1);
        const ushort4 pc = *(const ushort4*)(PROJ + (size_t)r * PLD + c);
        ushort4 pp = make_ushort4(0, 0, 0, 0), pn = pp;
        if (!first) pp = *(const ushort4*)(PROJ + (size_t)(r - 1) * PLD + c);
        if (!last) pn = *(const ushort4*)(PROJ + (size_t)(r + 1) * PLD + c);
        const float4 m4 = *(const float4*)(mu + c);
        float ps[4];
        ps[0] = bf2f(pc.x) + m4.x * (0.5f * (bf2f(pp.x) + bf2f(pn.x)) - bf2f(pc.x)); ps[1] = bf2f(pc.y) + m4.y * (0.5f * (bf2f(pp.y) + bf2f(pn.y)) - bf2f(pc.y));
        ps[2] = bf2f(pc.z) + m4.z * (0.5f * (bf2f(pp.z) + bf2f(pn.z)) - bf2f(pc.z)); ps[3] = bf2f(pc.w) + m4.w * (0.5f * (bf2f(pp.w) + bf2f(pn.w)) - bf2f(pc.w));
        bf16_t* dst;
        if (c < 512) dst = FR + (size_t)r * 512 + c;
        else if (c < 1024) dst = FK + (size_t)r * 512 + c - 512;
        else if (c < 1536) dst = FV + (size_t)r * 512 + c - 1024;
        else { dst = LIN + (size_t)r * 384 + c - 1536;
            if (c < 1664) { for (int j = 0; j < 4; ++j) ps[j] = tanhf(ps[j]); }
            else if (c >= 1792) { for (int j = 0; j < 4; ++j) ps[j] = sigmoidf(ps[j]); } }
        uint2 o; o.x = pk_bf16(ps[0], ps[1]); o.y = pk_bf16(ps[2], ps[3]);
        *(uint2*)dst = o;
    }
}
DI void phase_kk(const bf16_t* FR, const bf16_t* FK, const float* k_k, const float* r_k, bf16_t* FKK, float* BC, int bid, int nb) {
    const int lane = threadIdx.x & 63;
    for (int w = bid * 4 + (threadIdx.x >> 6); w < MT * 8; w += nb * 4) {
        const int r = w >> 3, h = w & 7, c = h * 64 + lane;
        const float k = bf2f(FK[(size_t)r * 512 + c]), rr = bf2f(FR[(size_t)r * 512 + c]);
        const float kk = k * k_k[c];
        const float ss = wave_sum(kk * kk);
        FKK[(size_t)r * 512 + c] = f2bf(kk * rsqrtf(ss + 1e-12f));
        const float bc = wave_sum(rr * k * r_k[c]);
        if (lane == 0) BC[(size_t)r * 8 + h] = bc;
    }
}
DI void phase_win_prep(const bf16_t* PROJ, bf16_t* Q2, bf16_t* K2, bf16_t* V2t, float scq, int bid, int nb) {
    for (int id = bid * 256 + threadIdx.x; id < MT * 12; id += nb * 256) {
        const int r = id / 12, hs = id % 12, b = r / TT, t = r % TT;
        if (hs < 8 && t < CTX) continue;
        const int col = hs < 8 ? O_WQ + hs * 64 : (hs < 10 ? O_WK + (hs - 8) * 64 : O_WV + (hs - 10) * 64);
        float v[64];
#pragma unroll
        for (int i = 0; i < 64; i += 8) { const bf16x8 x = *(const bf16x8*)(PROJ + (size_t)r * PLD + col + i);
#pragma unroll
            for (int j = 0; j < 8; ++j) v[i + j] = bf2f((bf16_t)x[j]); }
        if (hs < 10 && t >= CTX) { const int n = t - CTX, row = n >> 6, cl = n & 63;
#pragma unroll
            for (int i = 0; i < 16; ++i) { const float f = rope_freq(i, 16); rot(v[i], v[16 + i], (float)row * f); rot(v[32 + i], v[48 + i], (float)cl * f); } }
        if (hs < 8) { bf16_t* q = Q2 + ((size_t)(b * 8 + hs) * SEQ + (t - CTX)) * 64;
#pragma unroll
            for (int i = 0; i < 64; i += 2) *(unsigned*)(q + i) = pk_bf16(v[i] * scq, v[i + 1] * scq); }
        else if (hs < 10) { bf16_t* k = K2 + ((size_t)(b * 2 + hs - 8) * TT + t) * 64;
#pragma unroll
            for (int i = 0; i < 64; i += 2) *(unsigned*)(k + i) = pk_bf16(v[i], v[i + 1]); }
        else { bf16_t* vt = V2t + (size_t)(b * 2 + hs - 10) * 64 * TT + vperm(t);
#pragma unroll
            for (int i = 0; i < 64; ++i) vt[(size_t)i * TT] = f2bf(v[i]); }
    }
}
DI void rwkv_scan_item(char* smem, const char* ws, const float* k_a, int h, int b, int dir) {
    constexpr int T = 32;
    float (*sdec)[64] = (float (*)[64])smem; float (*skey)[64] = sdec + T; float (*snkk)[64] = skey + T; float (*sbb)[64] = snkk + T; float (*sr)[64] = sbb + T; float (*sv)[64] = sr + T;
    const bf16_t* FR = (const bf16_t*)(ws + OFF_FR); const bf16_t* FK = (const bf16_t*)(ws + OFF_FK); const bf16_t* FV = (const bf16_t*)(ws + OFF_FV); const bf16_t* FKK = (const bf16_t*)(ws + OFF_FKK);
    const bf16_t* FA = (const bf16_t*)(ws + (dir ? OFF_FA1 : OFF_FA0)); const bf16_t* FL = (const bf16_t*)(ws + (dir ? OFF_FL1 : OFF_FL0));
    bf16_t* Yp = (bf16_t*)(ws + OFF_Y) + ((size_t)(dir * 2 + b) * SEQ) * 512 + h * 64;
    const int tid = threadIdx.x, v = tid >> 2, qq = (tid & 3) * 16;
    float S[16];
#pragma unroll
    for (int j = 0; j < 16; ++j) S[j] = 0.f;
    for (int s0 = 0; s0 < TT; s0 += T) {
        __syncthreads();
        for (int e = tid; e < T * 64; e += 256) {
            const int s = e >> 6, j = e & 63, sg = s0 + s;
            const int t = dir == 0 ? sg : (sg < CTX ? CTX - 1 - sg : TT - 1 - (sg - CTX));
            const size_t o = ((size_t)b * TT + t) * 512 + h * 64 + j;
            const float k = bf2f(FK[o]), aa = bf2f(FA[o]), kk = bf2f(FKK[o]);
            sdec[s][j] = expf(bf2f(FL[o])); skey[s][j] = k * (1.f + (aa - 1.f) * k_a[h * 64 + j]); snkk[s][j] = -kk; sbb[s][j] = kk * aa; sr[s][j] = bf2f(FR[o]); sv[s][j] = bf2f(FV[o]);
        }
        __syncthreads();
        for (int s = 0; s < T; ++s) {
            float sa = 0.f;
#pragma unroll
            for (int j = 0; j < 16; ++j) sa += S[j] * snkk[s][qq + j];
            sa += __shfl_xor(sa, 1); sa += __shfl_xor(sa, 2);
            const float vv = sv[s][v];
            float y = 0.f;
#pragma unroll
            for (int j = 0; j < 16; ++j) { S[j] = S[j] * sdec[s][qq + j] + sa * sbb[s][qq + j] + vv * skey[s][qq + j]; y += S[j] * sr[s][qq + j]; }
            y += __shfl_xor(y, 1); y += __shfl_xor(y, 2);
            const int sg = s0 + s;
            if (sg >= CTX && (tid & 3) == 0) { const int n = dir == 0 ? sg - CTX : SEQ - 1 - (sg - CTX); Yp[(size_t)n * 512 + v] = f2bf(y); }
        }
    }
}
DI void phase_rwkv_out(const char* ws, const float* ln_g, const float* ln_b, int bid, int nb) {
    const bf16_t* Y = (const bf16_t*)(ws + OFF_Y); const bf16_t* FV = (const bf16_t*)(ws + OFF_FV); const bf16_t* FGT = (const bf16_t*)(ws + OFF_FGT); const float* BC = (const float*)(ws + OFF_BC); bf16_t* MIX = (bf16_t*)(ws + OFF_ABUF);
    const int lane = threadIdx.x & 63;
    for (int w = bid * 4 + (threadIdx.x >> 6); w < NB * SEQ * 8; w += nb * 4) {
        const int rl = w >> 3, h = w & 7, b = rl / SEQ, n = rl % SEQ, c = h * 64 + lane;
        const size_t r = (size_t)b * TT + CTX + n;
        const float y = bf2f(Y[((size_t)(0 * 2 + b) * SEQ + n) * 512 + c]) + bf2f(Y[((size_t)(1 * 2 + b) * SEQ + n) * 512 + c]);
        const float mean = wave_sum(y) * (1.f / 64.f);
        const float yc = y - mean;
        const float var = wave_sum(yc * yc) * (1.f / 64.f);
        const float yn = yc * rsqrtf(var + 64e-5f) * ln_g[c] + ln_b[c];
        const float bonus = BC[r * 8 + h] * bf2f(FV[r * 512 + c]);
        MIX[r * D + c] = f2bf((yn + bonus) * bf2f(FGT[r * 512 + c]));
    }
}
DI void phase_final(float* x, const float* g, int bid, int nb) {
    const int lane = threadIdx.x & 63;
    for (int r = bid * 4 + (threadIdx.x >> 6); r < NB * SEQ; r += nb * 4) {
        float* p = x + (size_t)r * D;
        float4 xv[4]; float ss = 0.f;
#pragma unroll
        for (int q = 0; q < 4; ++q) { xv[q] = *(const float4*)(p + q * 256 + lane * 4); ss += xv[q].x * xv[q].x + xv[q].y * xv[q].y + xv[q].z * xv[q].z + xv[q].w * xv[q].w; }
        ss = wave_sum(ss);
        const float rstd = rsqrtf(ss * (1.f / 1024.f) + 1e-6f);
#pragma unroll
        for (int q = 0; q < 4; ++q) { const float4 gg = *(const float4*)(g + q * 256 + lane * 4);
            *(float4*)(p + q * 256 + lane * 4) = make_float4(xv[q].x * rstd * gg.x, xv[q].y * rstd * gg.y, xv[q].z * rstd * gg.z, xv[q].w * rstd * gg.w); }
    }
}

enum { PH_PRO = 0, PH_L0_NORM, PH_L0_INPROJ, PH_L0_POST, PH_L0_UP, PH_L0_RSCAN, PH_L0_ATT, PH_L0_OUT, PH_L0_NORM2, PH_L0_TOPK, PH_L0_G1, PH_L0_G2,
       PH_L1_NORM, PH_L1_INPROJ, PH_L1_FEAT, PH_L1_LORA, PH_L1_SCAN, PH_L1_ROUT, PH_L1_OUT, PH_L1_NORM2, PH_L1_TOPK, PH_L1_G1, PH_L1_G2, PH_FINAL, PH_COUNT };

template <int LAYER> DI void phase_conv_moe(char* smem, const MArgs& a, int bid, int nb) {
    char* ws = a.ws; int n;
    for (int e = 0; e < NE; ++e) {
        const size_t wo = ((size_t)LAYER * NE + e) * D * FF;
        conv_wt(smem, a.in[31] + wo, D, FF, (bf16_t*)(ws + OFF_WMOE) + (size_t)e * 3072 * 1024, nullptr, ColGate(), bid, nb, n);
        conv_wt(smem, a.in[32] + wo, D, FF, (bf16_t*)(ws + OFF_WMOE) + (size_t)e * 3072 * 1024, nullptr, ColUp(), bid, nb, n);
        conv_wt(smem, a.in[33] + wo, FF, D, (bf16_t*)(ws + OFF_WD) + (size_t)e * 1024 * 1536, nullptr, ColId(), bid, nb, n);
    }
}
template <int LAYER> DI void phase_moe_g1(char* smem, const MArgs& a, int bid, int nb) {
    char* ws = a.ws;
    const int Mv = LAYER == 0 ? ESLOTS : 2 * CAP, tm = (Mv + 127) / 128, tn = 3072 / 128;
    for (int t = bid; t < NE * tm * tn; t += nb) {
        const int e = t / (tm * tn), r = t % (tm * tn), mt = r / tn, nt = r % tn;
        ARowsMoe ar{(const bf16_t*)(ws + OFF_ABUF), (const int*)(ws + OFF_IDX), (const int*)(ws + OFF_IDXC), e};
        EpUm ep{(bf16_t*)(ws + OFF_U) + (size_t)e * ESLOTS * FF, Mv};
        gemm_tile<true>(smem, ar, Mv, (const bf16_t*)(ws + OFF_WMOE) + (size_t)e * 3072 * 1024, D, D, mt * 128, nt * 128, ep);
    }
}
template <int LAYER> DI void phase_moe_g2(char* smem, const MArgs& a, int bid, int nb) {
    char* ws = a.ws;
    const int Mv = LAYER == 0 ? ESLOTS : 2 * CAP, tm = (Mv + 127) / 128, tn = D / 128;
    for (int t = bid; t < NE * tm * tn; t += nb) {
        const int e = t / (tm * tn), r = t % (tm * tn), mt = r / tn, nt = r % tn;
        ARowsPlain ar{(const bf16_t*)(ws + OFF_U) + (size_t)e * ESLOTS * FF, FF};
        EpScatterM ep{a.out, (float*)(ws + OFF_XCTX), (const float*)(ws + OFF_MOD) + LAYER * 3 * 6144, (const int*)(ws + OFF_IDX), (const int*)(ws + OFF_IDXC), (const float*)(ws + OFF_GATE), (const float*)(ws + OFF_GATEC), e, Mv};
        gemm_tile<false>(smem, ar, Mv, (const bf16_t*)(ws + OFF_WD) + (size_t)e * 1024 * 1536, FF, FF, mt * 128, nt * 128, ep);
    }
}

__global__ void __launch_bounds__(256, 2) mega(MArgs a) {
    extern __shared__ __attribute__((aligned(16))) char smem[];
    const int bid = blockIdx.x, nb = gridDim.x;
    char* ws = a.ws;
    volatile LAS unsigned* bst = (volatile LAS unsigned*)(smem + GEMM_LDS);
    if (threadIdx.x == 0) { bst[0] = 0u; bst[1] = 0u; bst[2] = 0u; bst[3] = 0u; }
    __syncthreads();
    XcdBarrier bar; bar.bar = (unsigned*)(ws + OFF_CTL); bar.x = 0; bar.st = bst;
    const bool multi = (a.ph_hi - a.ph_lo) > 1;
    if (multi) bar = xcd_barrier_post((unsigned*)(ws + OFF_CTL), bst);
    const float* MOD0 = (const float*)(ws + OFF_MOD); const float* MOD1 = MOD0 + 3 * 6144;
    bf16_t* ABUF = (bf16_t*)(ws + OFF_ABUF); bf16_t* PROJ = (bf16_t*)(ws + OFF_PROJ); float* XCTX = (float*)(ws + OFF_XCTX);
    float* AFF = (float*)(ws + OFF_AFF); float* AFFC = (float*)(ws + OFF_AFFC);
    const float LOG2E = 1.4426950408889634f;
#define IN(k) (a.ph_lo <= (k) && (k) < a.ph_hi)
#define SEAM(k) do { if (IN(k) && IN((k) + 1)) xcd_barrier(bar); } while (0)
    if (IN(PH_PRO)) {
        int n;
        phase_mod(smem, a, bid, nb);
        conv_wt(smem, a.in[9], 1024, EVEN_IN, (bf16_t*)(ws + WS_EVIN), nullptr, ColId(), bid, nb, n);
        for (size_t e = (size_t)bid * 256 + threadIdx.x; e < (size_t)96 * 1024; e += (size_t)nb * 256) ((bf16_t*)(ws + WS_EVIN))[(size_t)EVEN_IN * 1024 + e] = 0;
        conv_wt(smem, a.in[10], 1024, 1024, (bf16_t*)(ws + WS_EVOUT), nullptr, ColId(), bid, nb, n);
        conv_wt(smem, a.in[12], 256, 768, (bf16_t*)(ws + WS_UQ), nullptr, ColId(), bid, nb, n);
        conv_wt(smem, a.in[14], 128, 1024, (bf16_t*)(ws + WS_UKV), nullptr, ColId(), bid, nb, n);
        conv_wt(smem, a.in[16], 1024, ODD_IN, (bf16_t*)(ws + WS_ODIN), nullptr, ColId(), bid, nb, n);
        conv_wt(smem, a.in[17], 1024, 1024, (bf16_t*)(ws + WS_ODOUT), nullptr, ColId(), bid, nb, n);
        for (int d = 0; d < 2; ++d) {
            conv_wt(smem, a.in[20] + (size_t)d * 64 * 512, 64, 512, (bf16_t*)(ws + WS_W2) + (size_t)d * 512 * 64, nullptr, ColId(), bid, nb, n);
            conv_wt(smem, a.in[22] + (size_t)d * 64 * 512, 64, 512, (bf16_t*)(ws + WS_A2) + (size_t)d * 512 * 64, nullptr, ColId(), bid, nb, n);
        }
        conv_wt(smem, a.in[23], 128, 512, (bf16_t*)(ws + WS_G2), nullptr, ColId(), bid, nb, n);
        phase_conv_moe<0>(smem, a, bid, nb);
    }
    SEAM(PH_PRO);
    if (IN(PH_L0_NORM)) phase_norm_mod<false, false>(a.in[0], a.in[2], a.in[6], MOD0, 0, ABUF, nullptr, nullptr, nullptr, bid, nb);
    SEAM(PH_L0_NORM);
    if (IN(PH_L0_INPROJ)) {
        ARowsPlain ar{ABUF, D};
        EpStoreBf16 ep{PROJ, PLD, MT, EVEN_IN};
        const int tn = 2560 / 128, tm = MT / 128;
        for (int t = bid; t < tm * tn; t += nb) gemm_tile<true>(smem, ar, MT, (const bf16_t*)(ws + WS_EVIN), D, D, (t / tn) * 128, (t % tn) * 128, ep);
    }
    SEAM(PH_L0_INPROJ);
    if (IN(PH_L0_POST)) phase_post0(a, bid, nb);
    SEAM(PH_L0_POST);
    if (IN(PH_L0_UP)) {
        const int tm = MT / 128;
        for (int t = bid; t < tm * 14; t += nb) {
            const int mt = t / 14, nt = t % 14;
            if (nt < 6) { ARowsCol ar{PROJ, PLD, C_CQ}; EpQrope ep{(bf16_t*)(ws + OFF_Q), 0.10206207261596577f * LOG2E}; gemm_tile<true>(smem, ar, MT, (const bf16_t*)(ws + WS_UQ), 256, 256, mt * 128, nt * 128, ep); }
            else { ARowsCol ar{PROJ, PLD, C_CKV}; EpKVm ep{(bf16_t*)(ws + OFF_K), (bf16_t*)(ws + OFF_VT)}; gemm_tile<true>(smem, ar, MT, (const bf16_t*)(ws + WS_UKV), 128, 128, mt * 128, (nt - 6) * 128, ep); }
        }
#ifndef NO_RETKV
        for (int it = bid; it < 130 * 4 * 2; it += nb) ret_kv_item(smem, PROJ, (float*)(ws + OFF_KVS), it % 130, (it / 130) & 3, it / 520);
#endif
    }
    SEAM(PH_L0_UP);
    if (IN(PH_L0_RSCAN)) phase_ret_scan((float*)(ws + OFF_KVS), bid, nb);
    SEAM(PH_L0_RSCAN);
    if (IN(PH_L0_ATT)) {
        phase_mla_attn(smem, ws, bid, nb);
#ifndef NO_RETOUT
        for (int it = bid; it < 130 * 4 * 2; it += nb) ret_out_item(smem, PROJ, (const float*)(ws + OFF_KVS), a.in[15], ABUF, it % 130, (it / 130) & 3, it / 520);
#endif
    }
    SEAM(PH_L0_ATT);
    if (IN(PH_L0_OUT)) {
        ARowsPlain ar{ABUF, D};
        EpResM ep{a.in[0], a.in[2], a.out, XCTX, MOD0, 2, 0};
        const int tn = D / 128, tm = MT / 128;
        for (int t = bid; t < tm * tn; t += nb) gemm_tile<true>(smem, ar, MT, (const bf16_t*)(ws + WS_EVOUT), D, D, (t / tn) * 128, (t % tn) * 128, ep);
    }
    SEAM(PH_L0_OUT);
    if (IN(PH_L0_NORM2)) phase_norm_mod<true, false>(a.out, XCTX, a.in[7], MOD0, 3, ABUF, a.in[30], AFF, AFFC, bid, nb);
    SEAM(PH_L0_NORM2);
    if (IN(PH_L0_TOPK)) {
        for (int p = bid; p < 64; p += nb) { if (p < 32) topk_item<SEQ, CAP>(smem, AFF, (int*)(ws + OFF_IDX), (float*)(ws + OFF_GATE), p); else topk_item<CTX, CAPC>(smem, AFFC, (int*)(ws + OFF_IDXC), (float*)(ws + OFF_GATEC), p - 32); }
    }
    SEAM(PH_L0_TOPK);
    if (IN(PH_L0_G1)) phase_moe_g1<0>(smem, a, bid, nb);
    SEAM(PH_L0_G1);
    if (IN(PH_L0_G2)) phase_moe_g2<0>(smem, a, bid, nb);
    SEAM(PH_L0_G2);
    if (IN(PH_L1_NORM)) phase_norm_mod<false, false>(a.out, XCTX, a.in[6] + D, MOD1, 0, ABUF, nullptr, nullptr, nullptr, bid, nb);
    SEAM(PH_L1_NORM);
    if (IN(PH_L1_INPROJ)) {
        ARowsPlain ar{ABUF, D};
        EpStoreBf16 ep{PROJ, PLD, MT, ODD_IN};
        const int tn = ODD_IN / 128, tm = MT / 128;
        for (int t = bid; t < tm * tn; t += nb) gemm_tile<true>(smem, ar, MT, (const bf16_t*)(ws + WS_ODIN), D, D, (t / tn) * 128, (t % tn) * 128, ep);
    }
    SEAM(PH_L1_INPROJ);
    if (IN(PH_L1_FEAT)) {
        phase_shift(PROJ, a.in[18], (bf16_t*)(ws + OFF_FR), (bf16_t*)(ws + OFF_FK), (bf16_t*)(ws + OFF_FV), (bf16_t*)(ws + OFF_LIN), bid, nb);
#ifndef NO_WINPREP
        phase_win_prep(PROJ, (bf16_t*)(ws + OFF_Q2), (bf16_t*)(ws + OFF_K2), (bf16_t*)(ws + OFF_V2T), 0.125f * LOG2E, bid, nb);
#endif
    }
    SEAM(PH_L1_FEAT);
    if (IN(PH_L1_LORA)) {
        const int tm = MT / 128;
        for (int t = bid; t < tm * 20; t += nb) {
            const int mt = t / 20, q = (t % 20) / 4, nt = t % 4;
            if (q < 2) { ARowsCol ar{(const bf16_t*)(ws + OFF_LIN), 384, 64 * q}; EpLDm ep{(bf16_t*)(ws + (q ? OFF_FL1 : OFF_FL0)), a.in[19] + q * 512};
                gemm_tile<true>(smem, ar, MT, (const bf16_t*)(ws + WS_W2) + (size_t)q * 512 * 64, 64, 64, mt * 128, nt * 128, ep); }
            else if (q < 4) { const int d = q - 2; ARowsCol ar{(const bf16_t*)(ws + OFF_LIN), 384, 128 + 64 * d}; EpAAm ep{(bf16_t*)(ws + (d ? OFF_FA1 : OFF_FA0)), a.in[21] + d * 512};
                gemm_tile<true>(smem, ar, MT, (const bf16_t*)(ws + WS_A2) + (size_t)d * 512 * 64, 64, 64, mt * 128, nt * 128, ep); }
            else { ARowsCol ar{(const bf16_t*)(ws + OFF_LIN), 384, 256}; EpStoreBf16 ep{(bf16_t*)(ws + OFF_FGT), 512, MT, 512};
                gemm_tile<true>(smem, ar, MT, (const bf16_t*)(ws + WS_G2), 128, 128, mt * 128, nt * 128, ep); }
        }
        phase_kk((const bf16_t*)(ws + OFF_FR), (const bf16_t*)(ws + OFF_FK), a.in[24], a.in[26], (bf16_t*)(ws + OFF_FKK), (float*)(ws + OFF_BC), bid, nb);
    }
    SEAM(PH_L1_LORA);
    if (IN(PH_L1_SCAN)) {
        if (bid < 32 && nb > 64) rwkv_scan_item(smem, ws, a.in[25], bid & 7, (bid >> 3) & 1, bid >> 4);
        else if (nb > 64) { phase_win_attn(smem, ws, a.in[29], bid, nb, 32); phase_conv_moe<1>(smem, a, bid - 32, nb - 32); }
        else { for (int p = bid; p < 32; p += nb) rwkv_scan_item(smem, ws, a.in[25], p & 7, (p >> 3) & 1, p >> 4); phase_win_attn(smem, ws, a.in[29], bid, nb, 0); phase_conv_moe<1>(smem, a, bid, nb); }
    }
    SEAM(PH_L1_SCAN);
    if (IN(PH_L1_ROUT)) phase_rwkv_out(ws, a.in[27], a.in[28], bid, nb);
    SEAM(PH_L1_ROUT);
    if (IN(PH_L1_OUT)) {
        ARowsPlain ar{ABUF, D};
        EpResM ep{a.out, XCTX, a.out, XCTX, MOD1, 2, 1};
        const int tn = D / 128, tm = MT / 128;
        for (int t = bid; t < tm * tn; t += nb) gemm_tile<true>(smem, ar, MT, (const bf16_t*)(ws + WS_ODOUT), D, D, (t / tn) * 128, (t % tn) * 128, ep);
    }
    SEAM(PH_L1_OUT);
    if (IN(PH_L1_NORM2)) phase_norm_mod<true, true>(a.out, XCTX, a.in[7] + D, MOD1, 3, ABUF, a.in[30] + D * NE, AFF, AFFC, bid, nb);
    SEAM(PH_L1_NORM2);
    if (IN(PH_L1_TOPK)) { for (int p = bid; p < 32; p += nb) topk_item<SEQ, CAP>(smem, AFF, (int*)(ws + OFF_IDX), (float*)(ws + OFF_GATE), p); }
    SEAM(PH_L1_TOPK);
    if (IN(PH_L1_G1)) phase_moe_g1<1>(smem, a, bid, nb);
    SEAM(PH_L1_G1);
    if (IN(PH_L1_G2)) phase_moe_g2<1>(smem, a, bid, nb);
    SEAM(PH_L1_G2);
    if (IN(PH_FINAL)) phase_final(a.out, a.in[8], bid, nb);
#undef IN
#undef SEAM
}
constexpr int MEGA_LDS = GEMM_LDS + 64;

extern "C" void kernel_launch(void* const* d_in, const int* in_sizes, int n_in, void* d_out, int out_size, void* d_ws, size_t ws_size, hipStream_t st) {
    const float* x = (const float*)d_in[0]; const float* c = (const float*)d_in[1]; const float* ctx = (const float*)d_in[2]; const float* c_ctx = (const float*)d_in[3];
    const float* ada_w = (const float*)d_in[4]; const float* ada_b = (const float*)d_in[5]; const float* norm_mix_g = (const float*)d_in[6]; const float* norm_ffn_g = (const float*)d_in[7];
    const float* final_g = (const float*)d_in[8]; const float* ev_w_in = (const float*)d_in[9]; const float* ev_w_out = (const float*)d_in[10]; const float* q_norm_g = (const float*)d_in[11];
    const float* w_uq = (const float*)d_in[12]; const float* kv_norm_g = (const float*)d_in[13]; const float* w_ukv = (const float*)d_in[14]; const float* ret_norm_g = (const float*)d_in[15];
    const float* od_w_in = (const float*)d_in[16]; const float* od_w_out = (const float*)d_in[17]; const float* rwkv_mu = (const float*)d_in[18]; const float* rwkv_w0 = (const float*)d_in[19];
    const float* rwkv_w2 = (const float*)d_in[20]; const float* rwkv_a0 = (const float*)d_in[21]; const float* rwkv_a2 = (const float*)d_in[22]; const float* rwkv_g2 = (const float*)d_in[23];
    const float* rwkv_k_k = (const float*)d_in[24]; const float* rwkv_k_a = (const float*)d_in[25]; const float* rwkv_r_k = (const float*)d_in[26]; const float* rwkv_ln_g = (const float*)d_in[27];
    const float* rwkv_ln_b = (const float*)d_in[28]; const float* win_sink = (const float*)d_in[29]; const float* moe_router = (const float*)d_in[30]; const float* moe_w_gate = (const float*)d_in[31];
    const float* moe_w_up = (const float*)d_in[32]; const float* moe_w_down = (const float*)d_in[33];
    float* out = (float*)d_out; char* ws = (char*)d_ws;
    if (ws_size < WS_END) return;
    float* MOD = (float*)(ws + OFF_MOD); float* XCTX = (float*)(ws + OFF_XCTX); float* AFF = (float*)(ws + OFF_AFF); float* AFFC = (float*)(ws + OFF_AFFC);
    int* IDX = (int*)(ws + OFF_IDX); float* GATE = (float*)(ws + OFF_GATE); int* IDXC = (int*)(ws + OFF_IDXC); float* GATEC = (float*)(ws + OFF_GATEC); float* BC = (float*)(ws + OFF_BC);
    bf16_t* ABUF = (bf16_t*)(ws + OFF_ABUF); bf16_t* PROJ = (bf16_t*)(ws + OFF_PROJ);
    bf16_t* Q = (bf16_t*)(ws + OFF_Q); bf16_t* K = (bf16_t*)(ws + OFF_K); bf16_t* VT = (bf16_t*)(ws + OFF_VT); float* KVS = (float*)(ws + OFF_KVS); bf16_t* U = (bf16_t*)(ws + OFF_U);
    bf16_t* FR = (bf16_t*)(ws + OFF_FR); bf16_t* FK = (bf16_t*)(ws + OFF_FK); bf16_t* FV = (bf16_t*)(ws + OFF_FV); bf16_t* FKK = (bf16_t*)(ws + OFF_FKK);
    bf16_t* FA0 = (bf16_t*)(ws + OFF_FA0); bf16_t* FA1 = (bf16_t*)(ws + OFF_FA1); bf16_t* FL0 = (bf16_t*)(ws + OFF_FL0); bf16_t* FL1 = (bf16_t*)(ws + OFF_FL1);
    bf16_t* FGT = (bf16_t*)(ws + OFF_FGT); bf16_t* LIN = (bf16_t*)(ws + OFF_LIN); bf16_t* Y = (bf16_t*)(ws + OFF_Y);
    bf16_t* Q2 = (bf16_t*)(ws + OFF_Q2); bf16_t* K2 = (bf16_t*)(ws + OFF_K2); bf16_t* V2T = (bf16_t*)(ws + OFF_V2T);
    const float LOG2E = 1.4426950408889634f;
    static int grid = 0;
    if (grid == 0) {
        int dev = 0, cus = 0, per_cu = 0;
        hipGetDevice(&dev); hipDeviceGetAttribute(&cus, hipDeviceAttributeMultiprocessorCount, dev);
        hipFuncSetAttribute((const void*)mega, hipFuncAttributeMaxDynamicSharedMemorySize, MEGA_LDS);
        hipOccupancyMaxActiveBlocksPerMultiprocessor(&per_cu, (const void*)mega, 256, MEGA_LDS);
        (void)hipGetLastError();
        grid = cus * (per_cu < 2 ? (per_cu < 1 ? 1 : per_cu) : 2);
    }
    hipMemsetAsync(ws + OFF_CTL, 0, XCD_BAR_WORDS * sizeof(unsigned), st);
    MArgs ma{};
    for (int i = 0; i < 34; ++i) ma.in[i] = (const float*)d_in[i];
    ma.out = out; ma.ws = ws;
    auto launch_mega = [&](int lo, int hi) { ma.ph_lo = lo; ma.ph_hi = hi; hipLaunchKernelGGL(mega, dim3(grid), dim3(256), MEGA_LDS, st, ma); };

    launch_mega(0, PH_COUNT);
}
```
